# Optimizing an MI355X kernel written in HIP

```python
import jax, jax.numpy as jnp
from jax import lax
import numpy as np

D_MODEL = 2048
BATCH = 4
SEQ = 4096
DEPTH = 1

MIX_WIDTH = D_MODEL
HEAD_DIM = 128
DSWA_HEADS = (MIX_WIDTH // 2) // HEAD_DIM
DSWA_CONFIGS = ((128, 1), (512, 4), (2048, 16))
ROT_DIM = HEAD_DIM // 4
ROPE_THETA = 500000.0
MLA_HEADS = (MIX_WIDTH // 2) // HEAD_DIM
Q_LORA_RANK = 512
KV_LORA_RANK = 512
QK_NOPE_DIM = 128
QK_ROPE_DIM = 64
V_HEAD_DIM = 128
D_FF = 4 * D_MODEL
Q_BLOCK = 128
NORM_EPS = 1e-6
NEG_INF = -1e30

A_WIDTH = DSWA_HEADS * HEAD_DIM
IN_SPLITS = (A_WIDTH, 2 * A_WIDTH, 3 * A_WIDTH,
             3 * A_WIDTH + Q_LORA_RANK,
             3 * A_WIDTH + Q_LORA_RANK + KV_LORA_RANK)
IN_COLS = 3 * A_WIDTH + Q_LORA_RANK + KV_LORA_RANK + QK_ROPE_DIM
OUT_ROWS = DSWA_HEADS * HEAD_DIM + MLA_HEADS * V_HEAD_DIM

kernel_name = "hybrid_dilated_swa_mla_sandwich"


def _rmsnorm(x, gain):
    xf = x.astype(jnp.float32)
    xf = xf * lax.rsqrt(jnp.mean(xf * xf, axis=-1, keepdims=True) + NORM_EPS)
    return xf.astype(x.dtype) * gain


def _rope(x, positions, rot_dim):
    inv_freq = ROPE_THETA ** (-jnp.arange(0, rot_dim, 2, dtype=jnp.float32) / rot_dim)
    ang = positions.astype(jnp.float32)[..., None] * inv_freq
    cos = jnp.cos(ang)[:, :, None, :]
    sin = jnp.sin(ang)[:, :, None, :]
    xr = x[..., :rot_dim].astype(jnp.float32)
    x1, x2 = xr[..., : rot_dim // 2], xr[..., rot_dim // 2:]
    rot = jnp.concatenate([x1 * cos - x2 * sin, x2 * cos + x1 * sin], axis=-1)
    return jnp.concatenate([rot.astype(x.dtype), x[..., rot_dim:]], axis=-1)


def _dilated_window_attention(q, k, v, window, dilation):
    B, S, H, D = q.shape
    steps = window // dilation
    span = dilation * Q_BLOCK
    s_pad = -(-S // span) * span
    pad = ((0, 0), (0, s_pad - S), (0, 0), (0, 0))
    q, k, v = jnp.pad(q, pad), jnp.pad(k, pad), jnp.pad(v, pad)
    nb = s_pad // span
    qb = q.reshape(B, nb, Q_BLOCK, dilation, H, D)
    kb = k.reshape(B, nb, Q_BLOCK, dilation, H, D)
    vb = v.reshape(B, nb, Q_BLOCK, dilation, H, D)

    def with_prev(t):
        prev = jnp.pad(t[:, :-1], ((0, 0), (1, 0), (0, 0), (0, 0), (0, 0), (0, 0)))
        return jnp.concatenate([prev, t], axis=2)

    kc, vc = with_prev(kb), with_prev(vb)
    s = jnp.einsum('bniphd,bnjphd->bnphij', qb, kc).astype(jnp.float32) * (D ** -0.5)
    i = jnp.arange(Q_BLOCK)[:, None]
    j = jnp.arange(2 * Q_BLOCK)[None, :]
    dist = i + Q_BLOCK - j
    band = (dist >= 0) & (dist <= steps)
    first = (jnp.arange(nb) == 0)[:, None, None] & (j < Q_BLOCK)[None]
    mask = band[None] & ~first
    s = jnp.where(mask[None, :, None, None], s, NEG_INF)
    m = jnp.max(s, axis=-1, keepdims=True)
    p = jnp.exp(s - m)
    denom = jnp.sum(p, axis=-1, keepdims=True)
    o = jnp.einsum('bnphij,bnjphd->bniphd', (p / denom).astype(v.dtype), vc)
    lse = (m + jnp.log(denom))[..., 0]
    o = o.reshape(B, s_pad, H, D)[:, :S]
    lse = jnp.transpose(lse, (0, 1, 4, 2, 3)).reshape(B, s_pad, H)[:, :S]
    return o, lse


def _causal_block_attention(q, k, v, scale):
    B, S, H, Dk = q.shape
    nb = S // Q_BLOCK
    qb = q.reshape(B, nb, Q_BLOCK, H, Dk).transpose(1, 0, 2, 3, 4)
    key_pos = jnp.arange(S)

    def one_block(args):
        n, qn = args
        s = jnp.einsum('bqhd,bkhd->bhqk', qn, k).astype(jnp.float32) * scale
        q_pos = n * Q_BLOCK + jnp.arange(Q_BLOCK)
        s = jnp.where((key_pos[None, :] <= q_pos[:, None])[None, None], s, NEG_INF)
        p = jax.nn.softmax(s, axis=-1)
        return jnp.einsum('bhqk,bkhd->bqhd', p.astype(v.dtype), v)

    o = lax.map(one_block, (jnp.arange(nb), qb))
    return o.transpose(1, 0, 2, 3, 4).reshape(B, S, H, v.shape[-1])


def setup_inputs(seed: int = 0) -> dict:
    key = jax.random.key(seed)
    ks = jax.random.split(key, 16)
    f32 = jnp.float32

    def w(k, shape, fan_in):
        return jax.random.normal(k, shape, f32) * (fan_in ** -0.5)

    def gain(k, n):
        return 1.0 + 0.05 * jax.random.normal(k, (DEPTH, n), f32)

    x = jax.random.normal(ks[0], (BATCH, SEQ, D_MODEL), f32)
    offset = jax.random.randint(ks[1], (BATCH, 1), 0, 2048, dtype=jnp.int32)
    positions = offset + jnp.arange(SEQ, dtype=jnp.int32)[None, :]
    return {
        "x": x,
        "positions": positions,
        "norm_attn_pre": gain(ks[2], D_MODEL),
        "norm_attn_post": gain(ks[3], D_MODEL),
        "w_in": w(ks[4], (DEPTH, D_MODEL, IN_COLS), D_MODEL),
        "q_latent_norm": gain(ks[5], Q_LORA_RANK),
        "kv_latent_norm": gain(ks[6], KV_LORA_RANK),
        "w_uq": w(ks[7], (DEPTH, Q_LORA_RANK, MLA_HEADS * (QK_NOPE_DIM + QK_ROPE_DIM)), Q_LORA_RANK),
        "w_ukv": w(ks[8], (DEPTH, KV_LORA_RANK, MLA_HEADS * (QK_NOPE_DIM + V_HEAD_DIM)), KV_LORA_RANK),
        "w_out": w(ks[9], (DEPTH, OUT_ROWS, D_MODEL), OUT_ROWS),
        "norm_mlp_pre": gain(ks[10], D_MODEL),
        "norm_mlp_post": gain(ks[11], D_MODEL),
        "w_up": w(ks[12], (DEPTH, D_MODEL, D_FF), D_MODEL),
        "w_down": w(ks[13], (DEPTH, D_FF, D_MODEL), D_FF),
    }


def reference(x, positions, norm_attn_pre, norm_attn_post, w_in, q_latent_norm,
              kv_latent_norm, w_uq, w_ukv, w_out, norm_mlp_pre, norm_mlp_post,
              w_up, w_down):
    B, S, _ = x.shape
    for layer in range(DEPTH):
        h = _rmsnorm(x, norm_attn_pre[layer])
        proj = h @ w_in[layer]
        a_q, a_k, a_v, c_q, c_kv, k_r = jnp.split(proj, IN_SPLITS, axis=-1)

        a_q = _rope(a_q.reshape(B, S, DSWA_HEADS, HEAD_DIM), positions, ROT_DIM)
        a_k = _rope(a_k.reshape(B, S, DSWA_HEADS, HEAD_DIM), positions, ROT_DIM)
        a_v = a_v.reshape(B, S, DSWA_HEADS, HEAD_DIM)
        outs, lses = [], []
        for window, dilation in DSWA_CONFIGS:
            o, lse = _dilated_window_attention(a_q, a_k, a_v, window, dilation)
            outs.append(o)
            lses.append(lse)
        alpha = jax.nn.softmax(jnp.stack(lses, axis=0), axis=0)
        a_out = jnp.sum(alpha[..., None].astype(a_v.dtype) * jnp.stack(outs, axis=0), axis=0)

        c_q = _rmsnorm(c_q, q_latent_norm[layer])
        q_b = (c_q @ w_uq[layer]).reshape(B, S, MLA_HEADS, QK_NOPE_DIM + QK_ROPE_DIM)
        q_nope, q_rope = q_b[..., :QK_NOPE_DIM], q_b[..., QK_NOPE_DIM:]
        q_rope = _rope(q_rope, positions, QK_ROPE_DIM)
        c_kv = _rmsnorm(c_kv, kv_latent_norm[layer])
        kv = (c_kv @ w_ukv[layer]).reshape(B, S, MLA_HEADS, QK_NOPE_DIM + V_HEAD_DIM)
        k_nope, v_b = kv[..., :QK_NOPE_DIM], kv[..., QK_NOPE_DIM:]
        k_rope = _rope(k_r[:, :, None, :], positions, QK_ROPE_DIM)
        q_full = jnp.concatenate([q_nope, q_rope], axis=-1)
        k_full = jnp.concatenate(
            [k_nope, jnp.broadcast_to(k_rope, (B, S, MLA_HEADS, QK_ROPE_DIM))], axis=-1)
        b_out = _causal_block_attention(q_full, k_full, v_b,
                                        (QK_NOPE_DIM + QK_ROPE_DIM) ** -0.5)

        mixed = jnp.concatenate([a_out.reshape(B, S, DSWA_HEADS * HEAD_DIM),
                                 b_out.reshape(B, S, MLA_HEADS * V_HEAD_DIM)], axis=-1)
        x = x + _rmsnorm(mixed @ w_out[layer], norm_attn_post[layer])

        h = _rmsnorm(x, norm_mlp_pre[layer])
        u = jnp.square(jax.nn.relu(h @ w_up[layer]))
        x = x + _rmsnorm(u @ w_down[layer], norm_mlp_post[layer])
    return x
```

```cpp
#define MK_N_LAUNCHES 1
#include <hip/hip_runtime.h>
#include <hip/hip_cooperative_groups.h>
#include <cstdio>
#include <cstdint>
namespace cg = cooperative_groups;

#ifndef MK_N_LAUNCHES
#define MK_N_LAUNCHES 1
#endif
#ifndef FAST_GEMM
#define FAST_GEMM 1
#endif
#ifndef FAST_ATTN_A
#define FAST_ATTN_A 1
#endif
#ifndef FAST_ATTN_B
#define FAST_ATTN_B 1
#endif

#define LAS __attribute__((address_space(3)))
typedef unsigned short bf16_t;
typedef short bf16x8 __attribute__((ext_vector_type(8)));
typedef short s16x4 __attribute__((ext_vector_type(4)));
typedef float f32x4 __attribute__((ext_vector_type(4)));
typedef float f32x16 __attribute__((ext_vector_type(16)));
typedef unsigned u32x4 __attribute__((ext_vector_type(4)));
typedef unsigned u32x2 __attribute__((ext_vector_type(2)));

constexpr int NB = 4, SEQ = 4096, T = NB * SEQ, DM = 2048, NPROJ = 4352  , FF = 8192, NUP = 3584, LAT = 512;
constexpr float EPS = 1e-6f, LOG2E = 1.4426950408889634f;
constexpr float C2A = 0.08838834764831845f * LOG2E;
constexpr float C2B = 0.07216878364870323f * LOG2E;
constexpr int NTHREADS = 512, NWAVES = 8;
constexpr int LDS_BYTES = 155648, MISC_OFF = LDS_BYTES - 64;

constexpr size_t MiB = 1u << 20;
constexpr size_t WS_SSQ = 0;
constexpr size_t WS_BAR = 128 * 1024;
constexpr size_t WS_LSE = 256 * 1024;
constexpr size_t WS_COSA = 2 * MiB, WS_SINA = 3 * MiB;
constexpr size_t WS_COSB = 4 * MiB, WS_SINB = 6 * MiB;
constexpr size_t WS_BTIN = 8 * MiB;
constexpr size_t WS_BTUP = 25 * MiB;
constexpr size_t WS_BTOUT = 29 * MiB;
constexpr size_t WS_BTFU = 37 * MiB;
constexpr size_t WS_BTFD = 69 * MiB;
constexpr size_t WS_HB = 101 * MiB;
constexpr size_t WS_Y = 165 * MiB;
constexpr size_t WS_PROJ = 229 * MiB;
constexpr size_t WS_QB = 365 * MiB;
constexpr size_t WS_KVB = 413 * MiB;
constexpr size_t WS_U = 229 * MiB;
constexpr size_t WS_END = 485 * MiB;

struct Args {
    const float* x; const int* pos; const float* g_pre; const float* g_post; const float* w_in; const float* g_q; const float* g_kv;
    const float* w_uq; const float* w_ukv; const float* w_out; const float* g_pre2; const float* g_post2; const float* w_up; const float* w_down;
    float* out; unsigned char* ws; int ph_lo, ph_hi;
};

__device__ __forceinline__ unsigned cvt_pk_bf16(float lo, float hi) { unsigned r; asm volatile("v_cvt_pk_bf16_f32 %0, %1, %2" : "=v"(r) : "v"(lo), "v"(hi)); return r; }
__device__ __forceinline__ float bf_lo(unsigned w) { return __uint_as_float(w << 16); }
__device__ __forceinline__ float bf_hi(unsigned w) { return __uint_as_float(w & 0xffff0000u); }
__device__ __forceinline__ float bf2f(bf16_t h) { return __uint_as_float((unsigned)h << 16); }
__device__ __forceinline__ float wave_sum(float v) {
#pragma unroll
    for (int o = 1; o < 64; o <<= 1) v += __shfl_xor(v, o);
    return v;
}
__device__ __forceinline__ void store8(bf16_t* p, const float* v) {
    u32x4 w; w.x = cvt_pk_bf16(v[0], v[1]); w.y = cvt_pk_bf16(v[2], v[3]); w.z = cvt_pk_bf16(v[4], v[5]); w.w = cvt_pk_bf16(v[6], v[7]);
    *(u32x4*)p = w;
}
__device__ __forceinline__ void load8f(const bf16_t* p, float* v) {
    const u32x4 w = *(const u32x4*)p;
    v[0] = bf_lo(w.x); v[1] = bf_hi(w.x); v[2] = bf_lo(w.y); v[3] = bf_hi(w.y); v[4] = bf_lo(w.z); v[5] = bf_hi(w.z); v[6] = bf_lo(w.w); v[7] = bf_hi(w.w);
}

struct Ctx {
    bf16_t *PROJ, *QB, *KVB, *Y, *U;
    float* SSQ; const float *COSA, *SINA, *COSB, *SINB;
};
enum { EK_PROJ = 0, EK_UP = 1, EK_OUT = 2, EK_FU = 3 };
__device__ __forceinline__ void rope8(float* v, const float* cs, const float* sn) {
    const f32x4 c = *(const f32x4*)cs, s = *(const f32x4*)sn;
#pragma unroll
    for (int j = 0; j < 4; ++j) { const float a = v[j], b = v[4 + j]; v[j] = a * c[j] - b * s[j]; v[4 + j] = b * c[j] + a * s[j]; }
}
template <int KIND> __device__ __forceinline__ float epi8(const Ctx& C, int row, int col, float* v, float rs_q, float rs_kv) {
    if constexpr (KIND == EK_PROJ) {
        const int pn = col >> 8; float ss = 0.f;
        if (pn < 8) {
            const int c = col & 127;
            if (c < 32) { const int i0 = 4 * (c >> 3); rope8(v, C.COSA + (size_t)row * 16 + i0, C.SINA + (size_t)row * 16 + i0); }
            if (pn < 4) {
#pragma unroll
                for (int j = 0; j < 8; ++j) v[j] *= C2A;
            }
        } else if (pn >= 12 && pn < 16) {
#pragma unroll
            for (int j = 0; j < 8; ++j) ss += v[j] * v[j];
        } else if (pn == 16) {
            const int c = col - 4096;
            if (c < 64) { const int i0 = 16 * (c >> 5) + 4 * ((c & 31) >> 3); rope8(v, C.COSB + (size_t)row * 32 + i0, C.SINB + (size_t)row * 32 + i0); }
        }
        store8(C.PROJ + (size_t)row * NPROJ + col, v);
        return ss;
    } else if constexpr (KIND == EK_UP) {
        if (col < 1536) {
            if (col >= 1024) { const int P = (col - 1024) & 63; const int i0 = 16 * (P >> 5) + 4 * ((P & 31) >> 3); rope8(v, C.COSB + (size_t)row * 32 + i0, C.SINB + (size_t)row * 32 + i0); }
            const float sc = rs_q * C2B;
#pragma unroll
            for (int j = 0; j < 8; ++j) v[j] *= sc;
            store8(C.QB + (size_t)row * 1536 + col, v);
        } else {
#pragma unroll
            for (int j = 0; j < 8; ++j) v[j] *= rs_kv;
            store8(C.KVB + (size_t)row * 2048 + (col - 1536), v);
        }
        return 0.f;
    } else if constexpr (KIND == EK_OUT) {
        store8(C.Y + (size_t)row * DM + col, v); return 0.f;
    } else {
#pragma unroll
        for (int j = 0; j < 8; ++j) { const float r = fmaxf(v[j], 0.f); v[j] = r * r; }
        store8(C.U + (size_t)row * FF + col, v); return 0.f;
    }
}
__device__ __forceinline__ float rs_from_ssq(float ss) { return 1.0f / sqrtf(ss * (1.0f / LAT) + EPS); }

struct GemmDesc { const bf16_t* A; const bf16_t* Bt; int M, N, K, lda; int split_pn; int aoff0, aoff1;
    __device__ __forceinline__ int aoff(int pn) const { return pn < split_pn ? aoff0 : aoff1; } };
template <int KIND> __device__ void naive_gemm(const GemmDesc g, const Ctx& C) {
    const long total = (long)g.M * (g.N / 8);
    for (long idx = (long)blockIdx.x * NTHREADS + threadIdx.x; idx < total; idx += (long)gridDim.x * NTHREADS) {
        const int row = (int)(idx % g.M), col = (int)(idx / g.M) * 8;
        const bf16_t* a = (const bf16_t*)((const char*)g.A + g.aoff(col >> 8)) + (size_t)row * g.lda;
        const bf16_t* b = g.Bt + (size_t)col * g.K;
        float acc[8] = {0.f, 0.f, 0.f, 0.f, 0.f, 0.f, 0.f, 0.f};
        for (int k = 0; k < g.K; k += 8) {
            float av[8]; load8f(a + k, av);
#pragma unroll
            for (int j = 0; j < 8; ++j) { float bv[8]; load8f(b + (size_t)j * g.K + k, bv);
#pragma unroll
                for (int e = 0; e < 8; ++e) acc[j] += av[e] * bv[e]; }
        }
        float rq = 0.f, rkv = 0.f;
        if constexpr (KIND == EK_UP) { rq = rs_from_ssq(C.SSQ[row * 2]); rkv = rs_from_ssq(C.SSQ[row * 2 + 1]); }
        const float ss = epi8<KIND>(C, row, col, acc, rq, rkv);
        if constexpr (KIND == EK_PROJ) { const int pn = col >> 8; if (pn >= 12 && pn < 16) atomicAdd(C.SSQ + row * 2 + (pn >= 14 ? 1 : 0), ss); }
    }
}

namespace pg8 {
#define PG8_LAS __attribute__((address_space(3)))
constexpr int BM = 256, BK = 64, HALF = 128, HTB = HALF * BK * 2  , STAGE_BYTES = 8 * HTB, NXCD = 8, WGM = 8;
__host__ __device__ __forceinline__ int lds_byte(int r, int c) { const int st = (r >> 4) * 2 + (c >> 5), rr = r & 15, cc = c & 31, ob = rr * 64 + cc * 2; return st * 1024 + (ob ^ (((ob >> 9) & 1) << 5)); }
__host__ __device__ __forceinline__ void stage_rc(int b, int& R, int& C) { const int st = b / 1024, sb = b % 1024, swz = sb ^ (((sb >> 9) & 1) << 5); R = (st >> 1) * 16 + swz / 64; C = (st & 1) * 32 + (swz % 64) / 2; }
__host__ __device__ __forceinline__ int perm32(int rho) { const int n = rho >> 4, i = rho & 15; return 8 * (i >> 2) + 4 * n + (i & 3); }
struct Unit { int pm, pn; };
typedef GemmDesc Gemm;
struct StaticOrder {
    int nM, nN, nwg, G, c;
    __host__ __device__ void init(int M, int N, int G_, int c_) { nM = M / BM; nN = N / BM; nwg = nM * nN; G = G_; c = c_; }
    __host__ __device__ bool next(int i, Unit& u) const {
        const long L = (long)i * G + c; if (L >= nwg) return false;
        int wgid = (int)L; { const int q = nwg / NXCD, r = nwg % NXCD, xcd = wgid % NXCD, off = wgid / NXCD; wgid = (xcd < r ? xcd * (q + 1) : r * (q + 1) + (xcd - r) * q) + off; }
        const int nig = WGM * nN, gid = wgid / nig, fm = gid * WGM, gsz = (nM - fm) < WGM ? (nM - fm) : WGM;
        u.pm = fm + ((wgid % nig) % gsz); u.pn = (wgid % nig) / gsz; return true;
    }
    __device__ __forceinline__ void a_ready(const Unit&) const {}
    __device__ __forceinline__ void done(const Unit&) const {}
};
template <int KIND> struct EpiK {
    static constexpr bool PERM = true, AFTER_DRAIN = false;
    Ctx C;
    __device__ __forceinline__ void operator()(const f32x4 (&acc)[2][2][4][2], const Unit& u, int wr, int wc, int fr, int fq) const {
#pragma unroll
        for (int ai = 0; ai < 2; ++ai)
#pragma unroll
            for (int m = 0; m < 4; ++m) {
                const int row = u.pm * BM + ai * HALF + wr * 64 + m * 16 + fr;
                float rq = 0.f, rkv = 0.f, ssum = 0.f;
                if constexpr (KIND == EK_UP) { if (u.pn < 6) rq = rs_from_ssq(C.SSQ[row * 2]); else rkv = rs_from_ssq(C.SSQ[row * 2 + 1]); }
#pragma unroll
                for (int bj = 0; bj < 2; ++bj) {
                    const int col = u.pn * BM + bj * HALF + wc * 32 + fq * 8;
                    float v[8] = {acc[ai][bj][m][0][0], acc[ai][bj][m][0][1], acc[ai][bj][m][0][2], acc[ai][bj][m][0][3], acc[ai][bj][m][1][0], acc[ai][bj][m][1][1], acc[ai][bj][m][1][2], acc[ai][bj][m][1][3]};
                    ssum += epi8<KIND>(C, row, col, v, rq, rkv);
                }
                if constexpr (KIND == EK_PROJ) {
                    if (u.pn >= 12 && u.pn < 16) { ssum += __shfl_xor(ssum, 16); ssum += __shfl_xor(ssum, 32); if (fq == 0) atomicAdd(C.SSQ + row * 2 + (u.pn >= 14 ? 1 : 0), ssum); }
                }
            }
    }
};
template <class Epi, class Sched, bool ALIGN_EPI = false, bool SP2 = false>
__device__ __forceinline__ void gemm_phase(PG8_LAS unsigned char* lds, const Gemm g, const Sched& S, const Epi& E) {
    const int tid = threadIdx.x, wid = __builtin_amdgcn_readfirstlane(tid >> 6), lane = tid & 63, wr = wid >> 2, wc = wid & 3, fr = lane & 15, fq = lane >> 4;
    const int K = g.K, nt = K / BK;
    unsigned voffA[2], voffB[2];
#pragma unroll
    for (int i = 0; i < 2; ++i) { int R, C; stage_rc(tid * 16 + i * 8192, R, C); const int Rb = Epi::PERM ? ((R & ~31) + perm32(R & 31)) : R;
        voffA[i] = (unsigned)(R * g.lda + C) * 2u; voffB[i] = (unsigned)(Rb * K + C) * 2u; }
    const size_t kstep = (size_t)(BK * 2);
    const size_t hstepA = (size_t)HALF * g.lda * 2, hstepB = (size_t)HALF * K * 2;
    const size_t tstepA = 2 * hstepA, tstepB = 2 * hstepB;
    const unsigned ldsw = (unsigned)wid * 1024u;
    const int aoff = lds_byte(wr * 64 + fr, fq * 8), boff = lds_byte(wc * 32 + fr, fq * 8);
#define PG8_SA(b, h) (((b) * 2 + (h)) * HTB)
#define PG8_SB(b, h) ((4 + (b) * 2 + (h)) * HTB)
#define PG8_STAGE(bufoff, gbase, voff) do { _Pragma("unroll") for (int _i = 0; _i < 2; ++_i) \
        __builtin_amdgcn_global_load_lds((const unsigned*)((const char*)(gbase) + (voff)[_i]), (PG8_LAS unsigned*)(lds + (bufoff) + ldsw + _i * 8192), 16, 0, 0); } while (0)
#define PG8_LDA(dst, b, h) do { _Pragma("unroll") for (int m = 0; m < 4; ++m) _Pragma("unroll") for (int k = 0; k < 2; ++k) dst[m][k] = *(const PG8_LAS bf16x8*)(lds + PG8_SA(b, h) + aoff + m * 2048 + k * 1024); } while (0)
#define PG8_LDB(dst, b, h) do { _Pragma("unroll") for (int n = 0; n < 2; ++n) _Pragma("unroll") for (int k = 0; k < 2; ++k) dst[n][k] = *(const PG8_LAS bf16x8*)(lds + PG8_SB(b, h) + boff + n * 2048 + k * 1024); } while (0)
#define PG8_MMA(ai, bj, At, Bt) do { __builtin_amdgcn_s_setprio(1); _Pragma("unroll") for (int m = 0; m < 4; ++m) _Pragma("unroll") for (int n = 0; n < 2; ++n) _Pragma("unroll") for (int k = 0; k < 2; ++k) \
        acc[ai][bj][m][n] = __builtin_amdgcn_mfma_f32_16x16x32_bf16(Bt[n][k], At[m][k], acc[ai][bj][m][n], 0, 0, 0); __builtin_amdgcn_s_setprio(0); } while (0)
#define PG8_WAIT_V(n) asm volatile("s_waitcnt vmcnt(" #n ")" ::: "memory")
#define PG8_WAIT_L(n) asm volatile("s_waitcnt lgkmcnt(" #n ")" ::: "memory")
#define PG8_BAR __builtin_amdgcn_s_barrier()
#define PG8_SCHED __builtin_amdgcn_sched_barrier(0)
    Unit cur, nxt; int ui = 0;
    if (!S.next(0, cur)) return;
    f32x4 acc[2][2][4][2];
#pragma unroll
    for (int a = 0; a < 2; ++a)
#pragma unroll
        for (int b = 0; b < 2; ++b)
#pragma unroll
            for (int m = 0; m < 4; ++m)
#pragma unroll
                for (int n = 0; n < 2; ++n) acc[a][b][m][n] = (f32x4){0.f, 0.f, 0.f, 0.f};
    bf16x8 At[4][2], B0[2][2], B1[2][2];
    const char* cA = (const char*)g.A + g.aoff(cur.pn) + (size_t)cur.pm * tstepA; const char* cB = (const char*)g.Bt + (size_t)cur.pn * tstepB;
    S.a_ready(cur);
    if constexpr (SP2) {
        PG8_STAGE(PG8_SB(0, 0), cB, voffB); PG8_STAGE(PG8_SB(0, 1), cB + hstepB, voffB); PG8_STAGE(PG8_SA(0, 0), cA, voffA); PG8_STAGE(PG8_SA(0, 1), cA + hstepA, voffA);
        if (wr == 1) PG8_BAR;
        PG8_WAIT_V(2); PG8_BAR;
        PG8_STAGE(PG8_SB(1, 0), cB + kstep, voffB); PG8_STAGE(PG8_SA(1, 0), cA + kstep, voffA); PG8_STAGE(PG8_SB(1, 1), cB + hstepB + kstep, voffB);
        PG8_WAIT_V(6); PG8_BAR;
    } else {
        PG8_STAGE(PG8_SB(0, 0), cB, voffB); PG8_STAGE(PG8_SA(0, 0), cA, voffA); PG8_STAGE(PG8_SB(0, 1), cB + hstepB, voffB); PG8_STAGE(PG8_SA(0, 1), cA + hstepA, voffA);
        if (wr == 1) PG8_BAR;
        PG8_WAIT_V(4); PG8_BAR;
        PG8_STAGE(PG8_SB(1, 0), cB + kstep, voffB); PG8_STAGE(PG8_SA(1, 0), cA + kstep, voffA); PG8_STAGE(PG8_SB(1, 1), cB + hstepB + kstep, voffB);
        PG8_WAIT_V(6); PG8_BAR;
    }
    for (;;) {
        const bool has_next = S.next(ui + 1, nxt);
        const char* nA = has_next ? (const char*)g.A + g.aoff(nxt.pn) + (size_t)nxt.pm * tstepA : cA; const char* nB = has_next ? (const char*)g.Bt + (size_t)nxt.pn * tstepB : cB;
        for (int t = 0; t < nt; t += 2) {
            const bool last = (t == nt - 2);
            const char* a1 = cA + (size_t)(t + 1) * kstep;
            const char* a2 = last ? nA : cA + (size_t)(t + 2) * kstep; const char* b2 = last ? nB : cB + (size_t)(t + 2) * kstep;
            const char* a3 = a2 + kstep; const char* b3 = b2 + kstep;
            if (last && has_next) S.a_ready(nxt);
            if constexpr (SP2) {
            PG8_LDB(B0, 0, 0); PG8_LDB(B1, 0, 1); PG8_SCHED; PG8_LDA(At, 0, 0); PG8_STAGE(PG8_SA(1, 1), a1 + hstepA, voffA);
            PG8_WAIT_V(8); PG8_WAIT_L(0); PG8_BAR; PG8_MMA(0, 0, At, B0); PG8_MMA(0, 1, At, B1); PG8_BAR; PG8_SCHED;
            PG8_LDA(At, 0, 1); PG8_STAGE(PG8_SB(0, 0), b2, voffB); PG8_STAGE(PG8_SB(0, 1), b2 + hstepB, voffB); PG8_STAGE(PG8_SA(0, 0), a2, voffA);
            PG8_WAIT_V(8); PG8_WAIT_L(0); PG8_BAR; PG8_MMA(1, 0, At, B0); PG8_MMA(1, 1, At, B1); PG8_BAR; PG8_SCHED;
            PG8_LDB(B0, 1, 0); PG8_LDB(B1, 1, 1); PG8_SCHED; PG8_LDA(At, 1, 0); PG8_STAGE(PG8_SA(0, 1), a2 + hstepA, voffA);
            PG8_WAIT_V(8); PG8_WAIT_L(0); PG8_BAR; PG8_MMA(0, 0, At, B0); PG8_MMA(0, 1, At, B1); PG8_BAR; PG8_SCHED;
            PG8_LDA(At, 1, 1); PG8_STAGE(PG8_SB(1, 0), b3, voffB); PG8_STAGE(PG8_SB(1, 1), b3 + hstepB, voffB); PG8_STAGE(PG8_SA(1, 0), a3, voffA);
            PG8_WAIT_V(8); PG8_WAIT_L(0); PG8_BAR; PG8_MMA(1, 0, At, B0); PG8_MMA(1, 1, At, B1); PG8_BAR; PG8_SCHED;
            } else {
            PG8_LDB(B0, 0, 0); PG8_SCHED; PG8_LDA(At, 0, 0); PG8_STAGE(PG8_SA(1, 1), a1 + hstepA, voffA);
            PG8_WAIT_L(8); PG8_BAR; PG8_WAIT_L(0); PG8_MMA(0, 0, At, B0); PG8_BAR; PG8_SCHED;
            PG8_LDB(B1, 0, 1); PG8_STAGE(PG8_SB(0, 0), b2, voffB);
            PG8_BAR; PG8_WAIT_L(0); PG8_MMA(0, 1, At, B1); PG8_BAR;
            PG8_LDA(At, 0, 1); PG8_STAGE(PG8_SA(0, 0), a2, voffA);
            PG8_BAR; PG8_WAIT_L(0); PG8_MMA(1, 0, At, B0); PG8_BAR; PG8_SCHED;
            PG8_STAGE(PG8_SB(0, 1), b2 + hstepB, voffB);
            PG8_WAIT_V(6); PG8_BAR; PG8_MMA(1, 1, At, B1); PG8_BAR;
            PG8_LDB(B0, 1, 0); PG8_SCHED; PG8_LDA(At, 1, 0); PG8_STAGE(PG8_SA(0, 1), a2 + hstepA, voffA);
            PG8_WAIT_L(8); PG8_BAR; PG8_WAIT_L(0); PG8_MMA(0, 0, At, B0); PG8_BAR; PG8_SCHED;
            PG8_LDB(B1, 1, 1); PG8_STAGE(PG8_SB(1, 0), b3, voffB);
            PG8_BAR; PG8_WAIT_L(0); PG8_MMA(0, 1, At, B1); PG8_BAR;
            PG8_LDA(At, 1, 1); PG8_STAGE(PG8_SA(1, 0), a3, voffA);
            PG8_BAR; PG8_WAIT_L(0); PG8_MMA(1, 0, At, B0); PG8_BAR; PG8_SCHED;
            PG8_STAGE(PG8_SB(1, 1), b3 + hstepB, voffB);
            PG8_WAIT_V(6); PG8_BAR; PG8_MMA(1, 1, At, B1); PG8_BAR;
            }
        }
        if constexpr (ALIGN_EPI) { if (wr == 0) PG8_BAR; }
        if constexpr (!Epi::AFTER_DRAIN) { E(acc, cur, wr, wc, fr, fq); S.done(cur); }
        if (!has_next) break;
#pragma unroll
        for (int a = 0; a < 2; ++a)
#pragma unroll
            for (int b = 0; b < 2; ++b)
#pragma unroll
                for (int m = 0; m < 4; ++m)
#pragma unroll
                    for (int n = 0; n < 2; ++n) acc[a][b][m][n] = (f32x4){0.f, 0.f, 0.f, 0.f};
        cur = nxt; cA = nA; cB = nB; ++ui;
        if constexpr (ALIGN_EPI) { if (wr == 1) PG8_BAR; }
    }
    PG8_WAIT_V(0);
    if constexpr (!ALIGN_EPI) { if (wr == 0) PG8_BAR; }
    PG8_BAR;
    if constexpr (Epi::AFTER_DRAIN) { E.fused(acc, cur, wr, wc, fr, fq, lds, wid, lane); S.done(cur); }
#undef PG8_SA
#undef PG8_SB
#undef PG8_STAGE
#undef PG8_LDA
#undef PG8_LDB
#undef PG8_MMA
#undef PG8_WAIT_V
#undef PG8_WAIT_L
#undef PG8_BAR
#undef PG8_SCHED
}
}

__device__ __forceinline__ int permA(int p) { return 16 * ((p >> 2) & 1) + 4 * (p >> 3) + (p & 3); }
__device__ __forceinline__ int permB(int P) { const int g = P >> 5, p = P & 31; return 32 * ((p >> 2) & 1) + 16 * g + 4 * (p >> 3) + (p & 3); }
__device__ __forceinline__ void transpose_item(const float* __restrict__ W, int N, int k0, int srccol, const float* __restrict__ gain, bf16_t* WT, int K, int n0, LAS float* scr, int lane) {
    const int n0src = __builtin_amdgcn_readfirstlane(srccol);
    if (!gain && __all(srccol == n0src + lane)) {
        const int c4 = lane & 15, kq = lane >> 4;
#pragma unroll 8
        for (int i = 0; i < 16; ++i) { const int kk = kq + 4 * i; const f32x4 v = *(const f32x4*)(W + (size_t)(k0 + kk) * N + n0src + 4 * c4);
            LAS float* d = scr + kk * 65 + 4 * c4; d[0] = v.x; d[1] = v.y; d[2] = v.z; d[3] = v.w; }
    } else {
#pragma unroll 8
        for (int kk = 0; kk < 64; ++kk) { float v = srccol >= 0 ? W[(size_t)(k0 + kk) * N + srccol] : 0.f; if (gain) v *= gain[k0 + kk]; scr[kk * 65 + lane] = v; }
    }
    asm volatile("s_waitcnt lgkmcnt(0)" ::: "memory");
    const int c = lane & 7;
#pragma unroll
    for (int j = 0; j < 8; ++j) { const int n = (lane >> 3) + 8 * j; const LAS float* s = scr + (8 * c) * 65 + n;
        u32x4 o; o.x = cvt_pk_bf16(s[0 * 65], s[1 * 65]); o.y = cvt_pk_bf16(s[2 * 65], s[3 * 65]); o.z = cvt_pk_bf16(s[4 * 65], s[5 * 65]); o.w = cvt_pk_bf16(s[6 * 65], s[7 * 65]);
        *(u32x4*)(WT + (size_t)(n0 + n) * K + k0 + 8 * c) = o; }
    asm volatile("s_waitcnt lgkmcnt(0)" ::: "memory");
}
__device__ __forceinline__ void p0_prologue(const Args& a, LAS unsigned char* lds) {
    unsigned char* ws = a.ws;
    const int tid = threadIdx.x, lane = tid & 63, wave = tid >> 6;
    const int gw = blockIdx.x * NWAVES + wave, NGW = gridDim.x * NWAVES;
    const long gt = (long)blockIdx.x * NTHREADS + tid, NGT = (long)gridDim.x * NTHREADS;
    { float* ssq = (float*)(ws + WS_SSQ); for (long i = gt; i < (long)T * 2; i += NGT) ssq[i] = 0.f; }
    { float* ca = (float*)(ws + WS_COSA); float* sa = (float*)(ws + WS_SINA); float* cb = (float*)(ws + WS_COSB); float* sb = (float*)(ws + WS_SINB);
      const float l2t = 18.931568569324174f;
      for (long i = gt; i < (long)T * 32; i += NGT) { const int t = (int)(i >> 5), f = (int)(i & 31); const float p = (float)a.pos[t];
          { const float inv = exp2f(-(float)(2 * f) * (1.0f / 64.0f) * l2t); const float ang = p * inv; cb[i] = cosf(ang); sb[i] = sinf(ang); }
          if (f < 16) { const float inv = exp2f(-(float)(2 * f) * (1.0f / 32.0f) * l2t); const float ang = p * inv; ca[t * 16 + f] = cosf(ang); sa[t * 16 + f] = sinf(ang); } } }
    { bf16_t* HB = (bf16_t*)(ws + WS_HB);
      for (int m = gw; m < T; m += NGW) { const f32x4* xr = (const f32x4*)(a.x + (size_t)m * DM) + lane; f32x4 v[8]; float s = 0.f;
#pragma unroll
          for (int j = 0; j < 8; ++j) { v[j] = xr[64 * j]; s += (v[j].x * v[j].x + v[j].y * v[j].y) + (v[j].z * v[j].z + v[j].w * v[j].w); }
          const float rs = 1.0f / sqrtf(wave_sum(s) * (1.0f / DM) + EPS);
          u32x2* o = (u32x2*)(HB + (size_t)m * DM) + lane;
#pragma unroll
          for (int j = 0; j < 8; ++j) { const f32x4 g = *((const f32x4*)a.g_pre + lane + 64 * j); u32x2 w; w.x = cvt_pk_bf16(v[j].x * rs * g.x, v[j].y * rs * g.y); w.y = cvt_pk_bf16(v[j].z * rs * g.z, v[j].w * rs * g.w); o[64 * j] = w; } } }
    { LAS float* scr = (LAS float*)(lds + wave * 16640);
      constexpr int I_IN = (NPROJ / 64) * (DM / 64), I_UP = (NUP / 64) * (LAT / 64), I_OUT = (DM / 64) * (DM / 64), I_FU = (FF / 64) * (DM / 64), I_FD = (DM / 64) * (FF / 64);
      constexpr int NITEMS = I_IN + I_UP + I_OUT + I_FU + I_FD;
      for (int it = gw; it < NITEMS; it += NGW) {
          int r = it;
          if (r < I_IN) { const int nb = r % (NPROJ / 64), kb = r / (NPROJ / 64), n = nb * 64 + lane; int src;
              if (n < 2048) { const int c = n & 127; src = (n & ~127) + (c < 32 ? permA(c) : c); } else if (n < 4096) src = n; else { const int P = n - 4096; src = P < 64 ? 4096 + permB(P) : -1; }
              transpose_item(a.w_in, 4160, kb * 64, src, nullptr, (bf16_t*)(ws + WS_BTIN), DM, nb * 64, scr, lane); continue; } r -= I_IN;
          if (r < I_UP) { const int nb = r % (NUP / 64), kb = r / (NUP / 64), n = nb * 64 + lane;
              if (n < 1536) { int src; if (n < 1024) src = (n >> 7) * 192 + (n & 127); else { const int q = n - 1024; src = (q >> 6) * 192 + 128 + permB(q & 63); }
                  transpose_item(a.w_uq, 1536, kb * 64, src, a.g_q, (bf16_t*)(ws + WS_BTUP), LAT, nb * 64, scr, lane); }
              else transpose_item(a.w_ukv, 2048, kb * 64, n - 1536, a.g_kv, (bf16_t*)(ws + WS_BTUP), LAT, nb * 64, scr, lane);
              continue; } r -= I_UP;
          if (r < I_OUT) { const int nb = r % (DM / 64), kb = r / (DM / 64); transpose_item(a.w_out, DM, kb * 64, nb * 64 + lane, nullptr, (bf16_t*)(ws + WS_BTOUT), DM, nb * 64, scr, lane); continue; } r -= I_OUT;
          if (r < I_FU) { const int nb = r % (FF / 64), kb = r / (FF / 64); transpose_item(a.w_up, FF, kb * 64, nb * 64 + lane, nullptr, (bf16_t*)(ws + WS_BTFU), DM, nb * 64, scr, lane); continue; } r -= I_FU;
          { const int nb = r % (DM / 64), kb = r / (DM / 64); transpose_item(a.w_down, DM, kb * 64, nb * 64 + lane, nullptr, (bf16_t*)(ws + WS_BTFD), FF, nb * 64, scr, lane); }
      } }
}

__device__ __forceinline__ void row_pass1(const Args& a) {
    const int lane = threadIdx.x & 63, gw = blockIdx.x * NWAVES + (threadIdx.x >> 6), NGW = gridDim.x * NWAVES;
    const bf16_t* Y = (const bf16_t*)(a.ws + WS_Y); bf16_t* HB = (bf16_t*)(a.ws + WS_HB);
    for (int m = gw; m < T; m += NGW) {
        const f32x4* xr = (const f32x4*)(a.x + (size_t)m * DM) + lane; const u32x2* yr = (const u32x2*)(Y + (size_t)m * DM) + lane;
        f32x4 xv[8], yv[8]; float s = 0.f;
#pragma unroll
        for (int j = 0; j < 8; ++j) { xv[j] = xr[64 * j]; const u32x2 w = yr[64 * j]; yv[j] = (f32x4){bf_lo(w.x), bf_hi(w.x), bf_lo(w.y), bf_hi(w.y)};
            s += (yv[j].x * yv[j].x + yv[j].y * yv[j].y) + (yv[j].z * yv[j].z + yv[j].w * yv[j].w); }
        const float rs = 1.0f / sqrtf(wave_sum(s) * (1.0f / DM) + EPS); float s2 = 0.f;
#pragma unroll
        for (int j = 0; j < 8; ++j) { const f32x4 g = *((const f32x4*)a.g_post + lane + 64 * j); xv[j] = xv[j] + yv[j] * rs * g;
            s2 += (xv[j].x * xv[j].x + xv[j].y * xv[j].y) + (xv[j].z * xv[j].z + xv[j].w * xv[j].w); }
        const float rs2 = 1.0f / sqrtf(wave_sum(s2) * (1.0f / DM) + EPS);
        f32x4* orow = (f32x4*)(a.out + (size_t)m * DM) + lane; u32x2* hr = (u32x2*)(HB + (size_t)m * DM) + lane;
#pragma unroll
        for (int j = 0; j < 8; ++j) { orow[64 * j] = xv[j]; const f32x4 g = *((const f32x4*)a.g_pre2 + lane + 64 * j);
            u32x2 w; w.x = cvt_pk_bf16(xv[j].x * rs2 * g.x, xv[j].y * rs2 * g.y); w.y = cvt_pk_bf16(xv[j].z * rs2 * g.z, xv[j].w * rs2 * g.w); hr[64 * j] = w; }
    }
}
__device__ __forceinline__ void row_pass2(const Args& a) {
    const int lane = threadIdx.x & 63, gw = blockIdx.x * NWAVES + (threadIdx.x >> 6), NGW = gridDim.x * NWAVES;
    const bf16_t* Z = (const bf16_t*)(a.ws + WS_Y);
    for (int m = gw; m < T; m += NGW) {
        f32x4* orow = (f32x4*)(a.out + (size_t)m * DM) + lane; const u32x2* zr = (const u32x2*)(Z + (size_t)m * DM) + lane;
        f32x4 xv[8], zv[8]; float s = 0.f;
#pragma unroll
        for (int j = 0; j < 8; ++j) { xv[j] = orow[64 * j]; const u32x2 w = zr[64 * j]; zv[j] = (f32x4){bf_lo(w.x), bf_hi(w.x), bf_lo(w.y), bf_hi(w.y)};
            s += (zv[j].x * zv[j].x + zv[j].y * zv[j].y) + (zv[j].z * zv[j].z + zv[j].w * zv[j].w); }
        const float rs = 1.0f / sqrtf(wave_sum(s) * (1.0f / DM) + EPS);
#pragma unroll
        for (int j = 0; j < 8; ++j) { const f32x4 g = *((const f32x4*)a.g_post2 + lane + 64 * j); orow[64 * j] = xv[j] + zv[j] * rs * g; }
    }
}

__device__ void naive_attn_a(const Args& a) {
    const int lane = threadIdx.x & 63, gw = blockIdx.x * NWAVES + (threadIdx.x >> 6), NGW = gridDim.x * NWAVES;
    const bf16_t* PROJ = (const bf16_t*)(a.ws + WS_PROJ); bf16_t* MIX = (bf16_t*)(a.ws + WS_HB);
    for (int it = gw; it < T * 8; it += NGW) {
        const int t = it >> 3, hh = it & 7, s = t & (SEQ - 1);
        const unsigned qw = *(const unsigned*)(PROJ + (size_t)t * NPROJ + hh * 128 + 2 * lane); const float q0 = bf_lo(qw), q1 = bf_hi(qw);
        float m = -1e30f, l = 0.f, o0 = 0.f, o1 = 0.f;
        for (int c = 0; c < 3; ++c) { const int d = c == 0 ? 1 : (c == 1 ? 4 : 16);
            for (int k = 0; k <= 128; ++k) { if (s - k * d < 0) break; const size_t tk = (size_t)(t - k * d);
                const unsigned kw = *(const unsigned*)(PROJ + tk * NPROJ + 1024 + hh * 128 + 2 * lane), vw = *(const unsigned*)(PROJ + tk * NPROJ + 2048 + hh * 128 + 2 * lane);
                const float sc = wave_sum(q0 * bf_lo(kw) + q1 * bf_hi(kw));
                const float mn = fmaxf(m, sc), al = exp2f(m - mn), p = exp2f(sc - mn);
                l = l * al + p; o0 = o0 * al + p * bf_lo(vw); o1 = o1 * al + p * bf_hi(vw); m = mn; } }
        const float il = 1.0f / l;
        *(unsigned*)(MIX + (size_t)t * DM + hh * 128 + 2 * lane) = cvt_pk_bf16(o0 * il, o1 * il);
    }
}
__device__ void naive_attn_b(const Args& a) {
    const int lane = threadIdx.x & 63, gw = blockIdx.x * NWAVES + (threadIdx.x >> 6), NGW = gridDim.x * NWAVES;
    const bf16_t* PROJ = (const bf16_t*)(a.ws + WS_PROJ); const bf16_t* QB = (const bf16_t*)(a.ws + WS_QB); const bf16_t* KVB = (const bf16_t*)(a.ws + WS_KVB); bf16_t* MIX = (bf16_t*)(a.ws + WS_HB);
    for (int it = gw; it < T * 8; it += NGW) {
        const int t = it >> 3, hh = it & 7, s = t & (SEQ - 1), t0 = t - s;
        const unsigned qw = *(const unsigned*)(QB + (size_t)t * 1536 + hh * 128 + 2 * lane); const float q0 = bf_lo(qw), q1 = bf_hi(qw), q2 = bf2f(QB[(size_t)t * 1536 + 1024 + hh * 64 + lane]);
        float m = -1e30f, l = 0.f, o0 = 0.f, o1 = 0.f;
        for (int j = 0; j <= s; ++j) { const size_t tk = (size_t)(t0 + j);
            const unsigned kw = *(const unsigned*)(KVB + tk * 2048 + hh * 256 + 2 * lane), vw = *(const unsigned*)(KVB + tk * 2048 + hh * 256 + 128 + 2 * lane);
            const float kr = bf2f(PROJ[tk * NPROJ + 4096 + lane]);
            const float sc = wave_sum(q0 * bf_lo(kw) + q1 * bf_hi(kw) + q2 * kr);
            const float mn = fmaxf(m, sc), al = exp2f(m - mn), p = exp2f(sc - mn);
            l = l * al + p; o0 = o0 * al + p * bf_lo(vw); o1 = o1 * al + p * bf_hi(vw); m = mn; }
        const float il = 1.0f / l;
        *(unsigned*)(MIX + (size_t)t * DM + 1024 + hh * 128 + 2 * lane) = cvt_pk_bf16(o0 * il, o1 * il);
    }
}

namespace att {
constexpr int NW = 8, QBLK = 32, KVBLK = 64, QB = 256;
constexpr int SHM_V = KVBLK * 128 * 2;
constexpr float THR = 8.f;
#define SBAR() __builtin_amdgcn_sched_barrier(0)
__device__ __forceinline__ int v_st(int k, int c) { const int kk = (k & ~0xC) | ((k & 4) << 1) | ((k & 8) >> 1); return ((kk >> 3) * 4 + (c >> 5)) * 512 + ((kk & 7) * 32 + (c & 31)) * 2; }
__device__ __forceinline__ int v_rd_base(int lane) { return ((lane & 3) << 3) | (((lane >> 2) & 3) << 6) | (((lane >> 4) & 1) << 5) | (((lane >> 5) & 1) << 8); }
constexpr int v_rd_off(int d0, int ks, int half) { return d0 * 512 + ks * 4096 + half * 2048; }
__device__ __forceinline__ int crow(int r, int hi) { return (r & 3) + 8 * (r >> 2) + 4 * hi; }
__device__ __forceinline__ unsigned cvtpk(float lo, float hi) { unsigned r; asm volatile("v_cvt_pk_bf16_f32 %0, %1, %2" : "=v"(r) : "v"(lo), "v"(hi)); return r; }
__device__ __forceinline__ void mask_tile(f32x16& p0, f32x16& p1, int dq, unsigned W) {
    const float NEG = -__builtin_inff();
#pragma unroll
    for (int r = 0; r < 16; ++r) { const int c = (r & 3) + 8 * (r >> 2); if ((unsigned)(dq - c) >= W) p0[r] = NEG; if ((unsigned)(dq - c - 32) >= W) p1[r] = NEG; }
}
__device__ __forceinline__ void partialSM(f32x16& p0, f32x16& p1, float& m_reg, float& mn, float& alpha) {
    float pmax = p0[0];
#pragma unroll
    for (int r = 1; r < 16; ++r) pmax = fmaxf(pmax, p0[r]);
#pragma unroll
    for (int r = 0; r < 16; ++r) pmax = fmaxf(pmax, p1[r]);
    { auto rr = __builtin_amdgcn_permlane32_swap(__float_as_uint(pmax), __float_as_uint(pmax), false, false); pmax = fmaxf(__uint_as_float(rr[0]), __uint_as_float(rr[1])); }
    if (__builtin_expect(__all((pmax - m_reg) <= THR), 1)) { mn = m_reg; alpha = 1.f; }
    else { mn = fmaxf(m_reg, pmax); alpha = __builtin_amdgcn_exp2f(m_reg - mn); m_reg = mn; }
#pragma unroll
    for (int r = 0; r < 16; ++r) p0[r] = p0[r] - mn;
#pragma unroll
    for (int r = 0; r < 16; ++r) p1[r] = p1[r] - mn;
#pragma unroll
    for (int r = 0; r < 16; ++r) p0[r] = __builtin_amdgcn_exp2f(p0[r]);
}
__device__ __forceinline__ void finishSM(f32x16& p0, f32x16& p1, float alpha, float& l_reg, bf16x8& pa0, bf16x8& pa1, bf16x8& pa2, bf16x8& pa3) {
#pragma unroll
    for (int r = 0; r < 16; ++r) p1[r] = __builtin_amdgcn_exp2f(p1[r]);
    float ps = 0;
#pragma unroll
    for (int r = 0; r < 16; ++r) ps += p0[r];
#pragma unroll
    for (int r = 0; r < 16; ++r) ps += p1[r];
    { auto rr = __builtin_amdgcn_permlane32_swap(__float_as_uint(ps), __float_as_uint(ps), false, false); ps = __uint_as_float(rr[0]) + __uint_as_float(rr[1]); }
    l_reg = l_reg * alpha + ps;
#define PK4(P, B_, OUT) do { unsigned a0 = cvtpk(P[B_+0], P[B_+1]), a1 = cvtpk(P[B_+2], P[B_+3]);                          \
        unsigned b0 = cvtpk(P[B_+4], P[B_+5]), b1 = cvtpk(P[B_+6], P[B_+7]);                                             \
        auto r0 = __builtin_amdgcn_permlane32_swap(a0, b0, false, false); auto r1 = __builtin_amdgcn_permlane32_swap(a1, b1, false, false); \
        u32x4 w = {r0[0], r1[0], r0[1], r1[1]}; OUT = __builtin_bit_cast(bf16x8, w); } while (0)
    PK4(p0, 0, pa0); PK4(p0, 8, pa1); PK4(p1, 0, pa2); PK4(p1, 8, pa3);
#undef PK4
}
template <int DK, int QREG, bool SK>
__device__ __forceinline__ void qkt(f32x16& p0, f32x16& p1, LAS const char* Kslot, int r32, int hi, const bf16x8* qr, LAS const char* qlds, bool act) {
    if (SK && !act) { const float NEG = -__builtin_inff();
#pragma unroll
        for (int r = 0; r < 16; ++r) { p0[r] = NEG; p1[r] = NEG; } return; }
    p0 = f32x16{}; p1 = f32x16{};
    const int swz = (r32 & 7) << 4;
#pragma unroll
    for (int d0 = 0; d0 < DK / 16; ++d0) {
        LAS const char* a;
        if (d0 < 8) a = Kslot + r32 * 256 + ((((d0 & 3) * 16 + hi * 8) * 2) ^ swz) + (d0 >> 2) * 128;
        else a = Kslot + 16384 + r32 * 128 + ((((d0 - 8) * 16 + hi * 8) * 2) ^ swz);
        const bf16x8 b0 = *(LAS const bf16x8*)(a);
        const bf16x8 b1 = *(LAS const bf16x8*)(a + (d0 < 8 ? 32 * 256 : 32 * 128));
        bf16x8 qf; if (d0 < QREG) qf = qr[d0]; else qf = *(LAS const bf16x8*)(qlds + (d0 - QREG) * 1024);
        p0 = __builtin_amdgcn_mfma_f32_32x32x16_bf16(b0, qf, p0, 0, 0, 0);
        p1 = __builtin_amdgcn_mfma_f32_32x32x16_bf16(b1, qf, p1, 0, 0, 0); }
}
template <bool SK>
__device__ __forceinline__ void pv_tile(f32x16* o, int vb, bf16x8 pa0, bf16x8 pa1, bf16x8 pa2, bf16x8 pa3, bool act) {
    if (SK && !act) return;
#define TRRD(dst, off) asm volatile("ds_read_b64_tr_b16 %0, %1 offset:%2" : "=&v"(dst) : "v"(vb), "i"(off) : "memory")
#define PV_D0(d0) do { s16x4 l0, l1, l2, l3, h0, h1, h2, h3; constexpr int b_ = v_rd_off(d0, 0, 0); \
        TRRD(l0, b_); TRRD(h0, b_ + 2048); TRRD(l1, b_ + 4096); TRRD(h1, b_ + 6144); TRRD(l2, b_ + 8192); TRRD(h2, b_ + 10240); TRRD(l3, b_ + 12288); TRRD(h3, b_ + 14336); \
        asm volatile("s_waitcnt lgkmcnt(0)" ::: "memory"); SBAR(); \
        o[d0] = __builtin_amdgcn_mfma_f32_32x32x16_bf16(pa0, (bf16x8){l0[0], l0[1], l0[2], l0[3], h0[0], h0[1], h0[2], h0[3]}, o[d0], 0, 0, 0);   \
        o[d0] = __builtin_amdgcn_mfma_f32_32x32x16_bf16(pa1, (bf16x8){l1[0], l1[1], l1[2], l1[3], h1[0], h1[1], h1[2], h1[3]}, o[d0], 0, 0, 0);   \
        o[d0] = __builtin_amdgcn_mfma_f32_32x32x16_bf16(pa2, (bf16x8){l2[0], l2[1], l2[2], l2[3], h2[0], h2[1], h2[2], h2[3]}, o[d0], 0, 0, 0);   \
        o[d0] = __builtin_amdgcn_mfma_f32_32x32x16_bf16(pa3, (bf16x8){l3[0], l3[1], l3[2], l3[3], h3[0], h3[1], h3[2], h3[3]}, o[d0], 0, 0, 0); } while (0)
    PV_D0(0); PV_D0(1); PV_D0(2); PV_D0(3);
#undef PV_D0
#undef TRRD
}
__device__ __forceinline__ void glds16(const void* gsrc, unsigned lds_dst) { unsigned keep;
    asm volatile("s_mov_b32 %0, m0\n\ts_mov_b32 m0, %2\n\ts_nop 0\n\tglobal_load_lds_dwordx4 %1, off\n\ts_mov_b32 m0, %0" : "=&s"(keep) : "v"(gsrc), "s"(lds_dst) : "memory"); }
struct Blk {
    const bf16_t* Qn; const bf16_t* Qr; int ldq, ldqr;
    const bf16_t* Kn; const bf16_t* Kr; int ldk, ldkr;
    const bf16_t* V;
    bf16_t* O; int ldo;
    float* LSE; int ldl;
    int P0, W, skv;
};
template <int DK, bool SK>
__device__ __forceinline__ void attn_block(const Blk& B, LAS char* lds) {
    constexpr int SLOT_K = (DK == 192) ? 24576 : 16384, NKP = (DK == 192) ? 3 : 2, NVP = 2;
    constexpr int QREG = (DK == 192) ? 9 : 8;
    constexpr int OFF_K = 3 * SHM_V, OFF_WS = OFF_K + 3 * SLOT_K, OFF_Q = OFF_WS + 2048;
    const int tid = threadIdx.x, wid = __builtin_amdgcn_readfirstlane(tid >> 6), lane = tid & 63, r32 = lane & 31, hi = lane >> 5;
    const int W = B.W;
    const int lowk = B.P0 - W + 1; const int j_lo = lowk > 0 ? lowk / KVBLK : 0;
    int j_hi = (B.P0 + QB - 1) / KVBLK + 1; if (j_hi > B.skv / KVBLK) j_hi = B.skv / KVBLK;
    const int NT = j_hi - j_lo;
    const int qlo = B.P0 + wid * QBLK, qm = qlo + r32 - 4 * hi;
    LAS float* wsf = (LAS float*)(lds + OFF_WS) + wid * 64; LAS float* li_l = wsf; LAS float* al_l = wsf + 32;
    LAS char* qlds = lds + OFF_Q + wid * 3072 + lane * 16;
    const unsigned lds0 = (unsigned)(uintptr_t)lds;
    float m_reg = -1e30f, l_reg = 0; f32x16 o[4] = {};
    const int krow = 4 * wid + (lane >> 4);
    const unsigned offK = (unsigned)(krow * B.ldk + (((lane & 15) ^ (krow & 7)) << 3)) * 2u;
    const int rrow = 8 * wid + (lane >> 3);
    const unsigned offR = (unsigned)(rrow * B.ldkr + (((lane & 7) ^ (rrow & 7)) << 3)) * 2u;
    const int vkk = 8 * (wid >> 1) + ((lane & 31) >> 2), vk = (vkk & ~0xC) | ((vkk & 4) << 1) | ((vkk & 8) >> 1);
    const unsigned offV = (unsigned)(vk * B.ldk + 32 * (2 * (wid & 1) + (lane >> 5)) + (lane & 3) * 8) * 2u;
    const unsigned kdst = lds0 + OFF_K + wid * 1024, vdst = lds0 + wid * 1024;
#define KBASE(t) ((j_lo + (t)) * KVBLK)
#define DMA_K(t, slot) do { const size_t kbo_ = (size_t)KBASE(t) * (size_t)B.ldk * 2; const char* kb_ = (const char*)B.Kn + kbo_; \
        glds16(kb_ + offK, (unsigned)__builtin_amdgcn_readfirstlane(kdst + (slot) * SLOT_K)); glds16(kb_ + (size_t)B.ldk * 64 + offK, (unsigned)__builtin_amdgcn_readfirstlane(kdst + (slot) * SLOT_K + 8192)); \
        if constexpr (DK == 192) glds16((const char*)B.Kr + (size_t)KBASE(t) * (size_t)B.ldkr * 2 + offR, (unsigned)__builtin_amdgcn_readfirstlane(kdst + (slot) * SLOT_K + 16384)); } while (0)
#define DMA_V(t, slot) do { const char* vb_ = (const char*)B.V + (size_t)KBASE(t) * (size_t)B.ldk * 2; \
        glds16(vb_ + offV, (unsigned)__builtin_amdgcn_readfirstlane(vdst + (slot) * SHM_V)); glds16(vb_ + (size_t)B.ldk * 64 + offV, (unsigned)__builtin_amdgcn_readfirstlane(vdst + (slot) * SHM_V + 8192)); } while (0)
#define WAIT_BAR(N) asm volatile("s_waitcnt vmcnt(%0) lgkmcnt(0)\n\ts_barrier" :: "i"(N) : "memory")
#define RESC(a) do { if (__any((a) < 1.f)) { if (hi == 0) al_l[r32] = (a); asm volatile("s_waitcnt lgkmcnt(0)" ::: "memory");              \
                     _Pragma("unroll") for (int d_ = 0; d_ < 4; ++d_) _Pragma("unroll") for (int r = 0; r < 16; ++r) o[d_][r] *= al_l[crow(r, hi)]; } } while (0)
#define ACT(t) (KBASE(t) <= qlo + QBLK - 1 && KBASE(t) + KVBLK - 1 >= qlo - W + 1)
#define MASKT(P0_, P1_, t) do { const int kb_ = KBASE(t); if ((!SK || ACT(t)) && (kb_ + KVBLK - 1 > qlo || kb_ <= qlo + QBLK - 1 - W)) mask_tile(P0_, P1_, qm - kb_, (unsigned)W); } while (0)
    bf16x8 qr[QREG];
#pragma unroll
    for (int d0 = 0; d0 < 8; ++d0) qr[d0] = *(const bf16x8*)(B.Qn + (size_t)(wid * QBLK + r32) * B.ldq + d0 * 16 + hi * 8);
    if constexpr (DK == 192) {
        qr[8] = *(const bf16x8*)(B.Qr + (size_t)(wid * QBLK + r32) * B.ldqr + hi * 8);
#pragma unroll
        for (int d0 = 9; d0 < 12; ++d0) *(LAS bf16x8*)(qlds + (d0 - QREG) * 1024) = *(const bf16x8*)(B.Qr + (size_t)(wid * QBLK + r32) * B.ldqr + (d0 - 8) * 16 + hi * 8);
    }
    DMA_K(0, 0);
    if (NT > 1) DMA_K(1, 1);
    DMA_V(0, 0);
    if (NT > 1) { WAIT_BAR(NKP + NVP); } else { WAIT_BAR(NVP); }
    int sl_prev = 0, sl_cur = 0, sl_next = 1;
#define ROT() do { sl_prev = sl_cur; sl_cur = sl_next; sl_next = (sl_next == 2) ? 0 : sl_next + 1; } while (0)
#define ENDW(t) do { if ((t) + 2 < NT) { WAIT_BAR(NKP + NVP); } else if ((t) + 1 < NT) { WAIT_BAR(NVP); } else { WAIT_BAR(0); } } while (0)
#define ISSUE(t) do { if ((t) + 2 < NT) DMA_K((t) + 2, sl_prev_k); if ((t) + 1 < NT) DMA_V((t) + 1, sl_next); } while (0)
    f32x16 pA0, pA1, pB0, pB1; float mnA, mnB, alA, alB; bf16x8 pa0, pa1, pa2, pa3;
    { const int sl_prev_k = 2;
      ISSUE(0); SBAR();
      qkt<DK, QREG, SK>(pA0, pA1, lds + OFF_K + sl_cur * SLOT_K, r32, hi, qr, qlds, ACT(0));
      MASKT(pA0, pA1, 0); partialSM(pA0, pA1, m_reg, mnA, alA);
      ENDW(0); ROT(); }
#define STEP(PX0, PX1, mnX, alX, PY0, PY1, alY, t) do { const int sl_prev_k = sl_prev;                                        \
        ISSUE(t); SBAR();                                                                                                     \
        qkt<DK, QREG, SK>(PX0, PX1, lds + OFF_K + sl_cur * SLOT_K, r32, hi, qr, qlds, ACT(t));                               \
        finishSM(PY0, PY1, alY, l_reg, pa0, pa1, pa2, pa3); SBAR();                                                           \
        pv_tile<SK>(o, (int)lds0 + v_rd_base(lane) + sl_prev * SHM_V, pa0, pa1, pa2, pa3, ACT((t) - 1));                      \
        MASKT(PX0, PX1, (t)); partialSM(PX0, PX1, m_reg, mnX, alX);                                                           \
        RESC(alX); ENDW(t); ROT(); } while (0)
    int t = 1;
    for (; t + 1 < NT; t += 2) {
        STEP(pB0, pB1, mnB, alB, pA0, pA1, alA, t);
        STEP(pA0, pA1, mnA, alA, pB0, pB1, alB, t + 1);
    }
    if (t < NT) {
        STEP(pB0, pB1, mnB, alB, pA0, pA1, alA, t);
        finishSM(pB0, pB1, alB, l_reg, pa0, pa1, pa2, pa3); SBAR();
    } else {
        finishSM(pA0, pA1, alA, l_reg, pa0, pa1, pa2, pa3); SBAR();
    }
    pv_tile<SK>(o, (int)lds0 + v_rd_base(lane) + sl_prev * SHM_V, pa0, pa1, pa2, pa3, ACT(NT - 1));
    if (hi == 0) { li_l[r32] = l_reg; if (B.LSE) B.LSE[(size_t)(wid * QBLK + r32) * B.ldl] = m_reg + __builtin_amdgcn_logf(l_reg); }
    asm volatile("s_waitcnt lgkmcnt(0)" ::: "memory");
    float rli[16];
#pragma unroll
    for (int r = 0; r < 16; ++r) rli[r] = __builtin_amdgcn_rcpf(li_l[crow(r, hi)]);
    const char* Owb = (const char*)(B.O + (size_t)(wid * QBLK) * B.ldo);
    const unsigned ooff = (unsigned)(4 * hi * B.ldo + r32) * 2u;
#pragma unroll
    for (int r = 0; r < 16; ++r) { const char* rowp = Owb + (size_t)((r & 3) + 8 * (r >> 2)) * (size_t)B.ldo * 2;
#pragma unroll
        for (int d0 = 0; d0 < 4; ++d0) { const float v = o[d0][r] * rli[r]; const float vn = __shfl_xor(v, 1);
            if ((r32 & 1) == 0) *(unsigned*)(rowp + ooff + d0 * 64) = cvtpk(v, vn); } }
    asm volatile("s_waitcnt lgkmcnt(0)\n\ts_barrier" ::: "memory");
#undef KBASE
#undef DMA_K
#undef DMA_V
#undef WAIT_BAR
#undef RESC
#undef ACT
#undef MASKT
#undef ROT
#undef ENDW
#undef ISSUE
#undef STEP
}
#undef SBAR
}

__device__ __forceinline__ void fast_attn_a(const Args& a, LAS char* lds) {
    const bf16_t* PROJ = (const bf16_t*)(a.ws + WS_PROJ);
    float* LSE = (float*)(a.ws + WS_LSE);
    for (int it = blockIdx.x; it < 32 * 48; it += gridDim.x) {
        const int bh = it / 48, x = it % 48, b = bh >> 3, hh = bh & 7;
        int c, d, r, qb, slen;
        if (x < 16) { c = 0; d = 1; r = 0; qb = x; slen = 4096; } else if (x < 32) { c = 1; d = 4; r = (x - 16) >> 2; qb = (x - 16) & 3; slen = 1024; } else { c = 2; d = 16; r = x - 32; qb = 0; slen = 256; }
        const long row0 = (long)b * SEQ + r;
        att::Blk B;
        B.ldq = d * NPROJ; B.ldk = B.ldq; B.ldqr = 0; B.ldkr = 0; B.Qr = nullptr; B.Kr = nullptr;
        B.P0 = qb * 256; B.W = 129; B.skv = slen;
        B.Qn = PROJ + (row0 + (long)B.P0 * d) * NPROJ + hh * 128;
        B.Kn = PROJ + row0 * NPROJ + 1024 + hh * 128; B.V = PROJ + row0 * NPROJ + 2048 + hh * 128;
        if (c == 0) { B.O = (bf16_t*)(a.ws + WS_HB) + (row0 + (long)B.P0 * d) * DM + hh * 128; B.ldo = d * DM; }
        else { B.O = (bf16_t*)(a.ws + WS_Y + (size_t)(c - 1) * 32 * MiB) + (row0 + (long)B.P0 * d) * 1024 + hh * 128; B.ldo = d * 1024; }
        B.LSE = LSE + (size_t)c * T * 8 + (row0 + (long)B.P0 * d) * 8 + hh; B.ldl = d * 8;
        att::attn_block<128, true>(B, lds);
    }
}
__device__ __forceinline__ void merge_a(const Args& a) {
    const float* LSE = (const float*)(a.ws + WS_LSE); bf16_t* MIX = (bf16_t*)(a.ws + WS_HB);
    const bf16_t* O1 = (const bf16_t*)(a.ws + WS_Y); const bf16_t* O2 = (const bf16_t*)(a.ws + WS_Y + 32 * MiB);
    const long total = (long)T * 128;
    for (long idx = (long)blockIdx.x * NTHREADS + threadIdx.x; idx < total; idx += (long)gridDim.x * NTHREADS) {
        const long t = idx >> 7; const int cg8 = (int)(idx & 127), hh = cg8 >> 4;
        const float l0 = LSE[t * 8 + hh], l1 = LSE[(size_t)T * 8 + t * 8 + hh], l2 = LSE[(size_t)2 * T * 8 + t * 8 + hh];
        const float mx = fmaxf(l0, fmaxf(l1, l2)); float w0 = exp2f(l0 - mx), w1 = exp2f(l1 - mx), w2 = exp2f(l2 - mx); const float inv = 1.0f / (w0 + w1 + w2); w0 *= inv; w1 *= inv; w2 *= inv;
        float v0[8], v1[8], v2[8]; load8f(MIX + t * DM + cg8 * 8, v0); load8f(O1 + t * 1024 + cg8 * 8, v1); load8f(O2 + t * 1024 + cg8 * 8, v2);
#pragma unroll
        for (int j = 0; j < 8; ++j) v0[j] = w0 * v0[j] + w1 * v1[j] + w2 * v2[j];
        store8(MIX + t * DM + cg8 * 8, v0);
    }
}
__device__ __forceinline__ void fast_attn_b(const Args& a, LAS char* lds) {
    const bf16_t* PROJ = (const bf16_t*)(a.ws + WS_PROJ); const bf16_t* QB = (const bf16_t*)(a.ws + WS_QB); const bf16_t* KVB = (const bf16_t*)(a.ws + WS_KVB); bf16_t* MIX = (bf16_t*)(a.ws + WS_HB);
    for (int it = blockIdx.x; it < 256; it += gridDim.x) {
        const int bh = it >> 3, s8 = it & 7, b = bh >> 3, hh = bh & 7;
        for (int pass = 0; pass < 2; ++pass) {
            const int qb = pass ? 15 - s8 : s8; const long row0 = (long)b * SEQ;
            att::Blk B;
            B.P0 = qb * 256; B.W = 1 << 30; B.skv = SEQ;
            B.Qn = QB + (row0 + B.P0) * 1536 + hh * 128; B.ldq = 1536; B.Qr = QB + (row0 + B.P0) * 1536 + 1024 + hh * 64; B.ldqr = 1536;
            B.Kn = KVB + row0 * 2048 + hh * 256; B.ldk = 2048; B.Kr = PROJ + row0 * NPROJ + 4096; B.ldkr = NPROJ;
            B.V = KVB + row0 * 2048 + hh * 256 + 128;
            B.O = MIX + (row0 + B.P0) * DM + 1024 + hh * 128; B.ldo = DM; B.LSE = nullptr; B.ldl = 0;
            att::attn_block<192, false>(B, lds);
        }
    }
}


__device__ __forceinline__ void kr_phase(const Args& a, const Ctx& C) {
    const int tid = threadIdx.x, wid = tid >> 6, lane = tid & 63, r16 = lane & 15, quad = lane >> 4;
    const bf16_t* HB = (const bf16_t*)(a.ws + WS_HB); const bf16_t* BT = (const bf16_t*)(a.ws + WS_BTIN) + (size_t)4096 * DM;
    for (int it = blockIdx.x; it < T / 64; it += gridDim.x) {
        const int tok = it * 64 + (wid >> 1) * 16 + r16, nt0 = 2 * (wid & 1);
        const bf16_t* hp = HB + (size_t)tok * DM + quad * 8;
        const bf16_t* b0p = BT + (size_t)(nt0 * 16 + r16) * DM + quad * 8; const bf16_t* b1p = b0p + (size_t)16 * DM;
        f32x4 acc0 = {0.f, 0.f, 0.f, 0.f}, acc1 = {0.f, 0.f, 0.f, 0.f};
#pragma unroll 8
        for (int k0 = 0; k0 < DM; k0 += 32) {
            const bf16x8 hv = *(const bf16x8*)(hp + k0), w0 = *(const bf16x8*)(b0p + k0), w1 = *(const bf16x8*)(b1p + k0);
            acc0 = __builtin_amdgcn_mfma_f32_16x16x32_bf16(w0, hv, acc0, 0, 0, 0);
            acc1 = __builtin_amdgcn_mfma_f32_16x16x32_bf16(w1, hv, acc1, 0, 0, 0);
        }
#pragma unroll
        for (int e = 0; e < 2; ++e) { const int nt = nt0 + e; f32x4 v = e ? acc1 : acc0;
            f32x4 pv; pv.x = __shfl_xor(v.x, 16); pv.y = __shfl_xor(v.y, 16); pv.z = __shfl_xor(v.z, 16); pv.w = __shfl_xor(v.w, 16);
            const int i0 = 16 * (nt >> 1) + 8 * (nt & 1) + 4 * (quad >> 1);
            const f32x4 cs = *(const f32x4*)(C.COSB + (size_t)tok * 32 + i0), sn = *(const f32x4*)(C.SINB + (size_t)tok * 32 + i0);
            f32x4 o; if ((quad & 1) == 0) o = v * cs - pv * sn; else o = v * cs + pv * sn;
            u32x2 w; w.x = cvt_pk_bf16(o.x, o.y); w.y = cvt_pk_bf16(o.z, o.w);
            *(u32x2*)(C.PROJ + (size_t)tok * NPROJ + 4096 + nt * 16 + quad * 4) = w; }
    }
}

#define RLX_AGENT __ATOMIC_RELAXED, __HIP_MEMORY_SCOPE_AGENT
#define XB_TMO      128
#define XB_XCNT(j)  (256  + 64 * (j))
#define XB_XSUB(j)  (1280 + 64 * (j))
#define XB_XGEN(j)  (2304 + 64 * (j))
#define XB_TOP      3328
#define XB_TOPGEN   3392
#define XCD_BAR_WORDS 3456
#define XB_SPIN_CAP (1u << 18)

__device__ __forceinline__ unsigned xb_ld(unsigned* p)              { return __hip_atomic_load(p, __ATOMIC_RELAXED, __HIP_MEMORY_SCOPE_AGENT); }
__device__ __forceinline__ unsigned xb_add(unsigned* p, unsigned v) { return __hip_atomic_fetch_add(p, v, __ATOMIC_RELAXED, __HIP_MEMORY_SCOPE_AGENT); }
__device__ __forceinline__ unsigned xb_xcc_id() { return (unsigned)__builtin_amdgcn_s_getreg((3 << 11) | 20) & 0xFu; }
#define XB_SPIN(cond, bar) do { unsigned _sp = 0; while (cond) { __builtin_amdgcn_s_sleep(1); \
    if ((++_sp & 255u) == 0u) { if (xb_ld(&(bar)[XB_TMO])) break; if (_sp > XB_SPIN_CAP) { atomicAdd(&(bar)[XB_TMO], 1u); break; } } } } while (0)

struct XcdBarrier {
    unsigned* bar; unsigned x;
    volatile LAS unsigned* st;
};

__device__ __forceinline__ XcdBarrier xcd_barrier_post(unsigned* bar, volatile LAS unsigned* st) {
    XcdBarrier b; b.bar = bar; b.x = xb_xcc_id(); b.st = st;
    if (threadIdx.x == 0) (void)xb_add(&bar[XB_XCNT(b.x)], 1u);
    return b;
}
__device__ __forceinline__ void xcd_barrier_complete(unsigned* bar, unsigned x, unsigned& nloc, unsigned& nx) {
    const unsigned G = gridDim.x * gridDim.y * gridDim.z;
    unsigned sum, cnt, mine, sp = 0u;
    for (;;) {
        sum = 0u; cnt = 0u; mine = 0u;
#pragma unroll
        for (unsigned j = 0; j < 16; ++j) { const unsigned c = xb_ld(&bar[XB_XCNT(j)]); sum += c; cnt += (c > 0u) ? 1u : 0u; mine = (j == x) ? c : mine; }
        if (sum == G) break;
        __builtin_amdgcn_s_sleep(1);
        if ((++sp & 255u) == 0u) { if (xb_ld(&bar[XB_TMO])) break; if (sp > XB_SPIN_CAP) { atomicAdd(&bar[XB_TMO], 1u); break; } }
    }
    nloc = mine > 0u ? mine : 1u; nx = cnt > 0u ? cnt : 1u;
}

__device__ __forceinline__ void xcd_barrier(const XcdBarrier& b) {
    asm volatile("s_waitcnt vmcnt(0)" ::: "memory");
    __syncthreads();
    if (threadIdx.x == 0) {
        unsigned* bar = b.bar;
        __builtin_amdgcn_s_waitcnt(0);
        unsigned nloc = b.st[0], nx = b.st[1];
        if (nloc == 0u) { xcd_barrier_complete(bar, b.x, nloc, nx); b.st[0] = nloc; b.st[1] = nx; }
        const unsigned old = xb_add(&bar[XB_XSUB(b.x)], 1u);
        const unsigned gen = old / nloc;
        if (old + 1u == (gen + 1u) * nloc) {
            __builtin_amdgcn_fence(__ATOMIC_RELEASE, "agent");
            asm volatile("s_waitcnt vmcnt(0)" ::: "memory");
            const unsigned og = xb_add(&bar[XB_TOP], 1u);
            const unsigned tg = og / nx;
            if (og + 1u == (tg + 1u) * nx) xb_add(&bar[XB_TOPGEN], 1u);
            else XB_SPIN(xb_ld(&bar[XB_TOPGEN]) == tg, bar);
            __builtin_amdgcn_fence(__ATOMIC_ACQUIRE, "agent");
            xb_add(&bar[XB_XGEN(b.x)], 1u);
            asm volatile("s_waitcnt vmcnt(0)" ::: "memory");
        } else {
            XB_SPIN(xb_ld(&bar[XB_XGEN(b.x)]) == gen, bar);
            __builtin_amdgcn_fence(__ATOMIC_ACQUIRE, "agent");
            asm volatile("s_waitcnt vmcnt(0)" ::: "memory");
        }
    }
    __syncthreads();
}

__global__ void __launch_bounds__(NTHREADS) hybrid_fwd(Args args) {
    extern __shared__ __attribute__((aligned(16))) unsigned char lds_raw[];
    LAS unsigned char* lds = (LAS unsigned char*)lds_raw;
    cg::grid_group grid = cg::this_grid();
    unsigned char* ws = args.ws;
    volatile LAS unsigned* MISC = (volatile LAS unsigned*)(lds + MISC_OFF);
    if (threadIdx.x < 16) MISC[threadIdx.x] = 0u;
    __syncthreads();
    XcdBarrier bar = xcd_barrier_post((unsigned*)(ws + WS_BAR), MISC + 8);
    if (args.ph_hi > 1000) grid.sync();
    Ctx C; C.PROJ = (bf16_t*)(ws + WS_PROJ); C.QB = (bf16_t*)(ws + WS_QB); C.KVB = (bf16_t*)(ws + WS_KVB); C.Y = (bf16_t*)(ws + WS_Y); C.U = (bf16_t*)(ws + WS_U);
    C.SSQ = (float*)(ws + WS_SSQ); C.COSA = (const float*)(ws + WS_COSA); C.SINA = (const float*)(ws + WS_SINA); C.COSB = (const float*)(ws + WS_COSB); C.SINB = (const float*)(ws + WS_SINB);
    const int lo = args.ph_lo, hi = args.ph_hi;
#define IN(k) (lo <= (k) && (k) < hi)
#define SEAM(k) do { if (IN(k) && IN((k) + 1)) xcd_barrier(bar); } while (0)
#define GSYNC() xcd_barrier(bar)
#if FAST_GEMM
#define RUN_GEMM(KIND, g) do { pg8::StaticOrder S_; S_.init((g).M, (g).N, (int)gridDim.x, (int)blockIdx.x); pg8::EpiK<KIND> E_{C}; \
        pg8::gemm_phase<pg8::EpiK<KIND>, pg8::StaticOrder, true, true>(lds, (g), S_, E_); __syncthreads(); } while (0)
#else
#define RUN_GEMM(KIND, g) naive_gemm<KIND>((g), C)
#endif
#ifndef PROBE_MASK
#define PROBE_MASK 0
#endif
#define PH0() do { if (IN(0)) { p0_prologue(args, lds); } } while (0)
#define PH1() do { if (IN(1)) { const GemmDesc g{(const bf16_t*)(ws + WS_HB), (const bf16_t*)(ws + WS_BTIN), T, 4096, DM, DM, 0, 0, 0}; RUN_GEMM(EK_PROJ, g); kr_phase(args, C); } } while (0)
#if FAST_ATTN_A
#define PH2A() fast_attn_a(args, (LAS char*)lds)
#define PH3A() merge_a(args)
#else
#define PH2A() naive_attn_a(args)
#define PH3A() do {} while (0)
#endif
#if FAST_ATTN_B
#define PH3B() fast_attn_b(args, (LAS char*)lds)
#else
#define PH3B() naive_attn_b(args)
#endif
#define PH2() do { if (IN(2)) { const GemmDesc g{(const bf16_t*)(ws + WS_PROJ), (const bf16_t*)(ws + WS_BTUP), T, NUP, LAT, NPROJ, 6, 3072 * 2, 3584 * 2}; RUN_GEMM(EK_UP, g); PH2A(); } } while (0)
#define PH3() do { if (IN(3)) { PH3A(); PH3B(); } } while (0)
#define PH4() do { if (IN(4)) { const GemmDesc g{(const bf16_t*)(ws + WS_HB), (const bf16_t*)(ws + WS_BTOUT), T, DM, DM, DM, 0, 0, 0}; RUN_GEMM(EK_OUT, g); } } while (0)
#define PH5() do { if (IN(5)) { row_pass1(args); } } while (0)
#define PH6() do { if (IN(6)) { const GemmDesc g{(const bf16_t*)(ws + WS_HB), (const bf16_t*)(ws + WS_BTFU), T, FF, DM, DM, 0, 0, 0}; RUN_GEMM(EK_FU, g); } } while (0)
#define PH7() do { if (IN(7)) { const GemmDesc g{(const bf16_t*)(ws + WS_U), (const bf16_t*)(ws + WS_BTFD), T, DM, FF, FF, 0, 0, 0}; RUN_GEMM(EK_OUT, g); } } while (0)
    PH0();
#if (PROBE_MASK >> 0) & 1
    GSYNC(); PH0();
#endif
    SEAM(0);
    PH1();
    SEAM(1);
    PH2();
    SEAM(2);
    PH3();
#if (PROBE_MASK >> 2) & 1
    GSYNC(); PH2(); GSYNC(); PH3();
#endif
#if (PROBE_MASK >> 8) & 1
    GSYNC(); PH2A(); GSYNC(); PH3A();
#endif
#if (PROBE_MASK >> 9) & 1
    GSYNC(); PH3B();
#endif
#if (PROBE_MASK >> 10) & 1
    for (int i_ = 0; i_ < 20; ++i_) GSYNC();
#endif
    SEAM(3);
    PH4();
#if (PROBE_MASK >> 4) & 1
    GSYNC(); PH4();
#endif
    SEAM(4);
    PH5();
#if (PROBE_MASK >> 5) & 1
    GSYNC(); PH5();
#endif
    SEAM(5);
    PH6();
#if (PROBE_MASK >> 6) & 1
    GSYNC(); PH6();
#endif
    SEAM(6);
    PH7();
#if (PROBE_MASK >> 7) & 1
    GSYNC(); PH7();
#endif
    SEAM(7);
    if (IN(8)) { row_pass2(args); }
}

extern "C" void kernel_launch(void* const* d_in, const int* in_sizes, int n_in, void* d_out, int out_size, void* d_ws, size_t ws_size, hipStream_t stream) {
    static int grid = 0;
    if (grid == 0) {
        if (n_in != 14 || in_sizes[0] != T * DM || out_size != T * DM || ws_size < WS_END) { fprintf(stderr, "kernel_launch: unexpected shapes / workspace (n_in %d, ws %zu, need %zu)\n", n_in, ws_size, (size_t)WS_END); grid = -1; return; }
        int dev = 0, cus = 0, per_cu = 0;
        (void)hipGetDevice(&dev); (void)hipDeviceGetAttribute(&cus, hipDeviceAttributeMultiprocessorCount, dev);
        if (hipFuncSetAttribute((const void*)hybrid_fwd, hipFuncAttributeMaxDynamicSharedMemorySize, LDS_BYTES) != hipSuccess) { fprintf(stderr, "kernel_launch: hipFuncSetAttribute failed\n"); grid = -1; return; }
        if (hipOccupancyMaxActiveBlocksPerMultiprocessor(&per_cu, (const void*)hybrid_fwd, NTHREADS, LDS_BYTES) != hipSuccess || per_cu < 1) { fprintf(stderr, "kernel_launch: occupancy query failed (%d)\n", per_cu); (void)hipGetLastError(); per_cu = 1; }
        grid = cus * (per_cu > 1 ? 1 : per_cu);
        if (grid <= 0) grid = 256;
    }
    if (grid < 0) return;
    Args a{};
    a.x = (const float*)d_in[0]; a.pos = (const int*)d_in[1]; a.g_pre = (const float*)d_in[2]; a.g_post = (const float*)d_in[3]; a.w_in = (const float*)d_in[4];
    a.g_q = (const float*)d_in[5]; a.g_kv = (const float*)d_in[6]; a.w_uq = (const float*)d_in[7]; a.w_ukv = (const float*)d_in[8]; a.w_out = (const float*)d_in[9];
    a.g_pre2 = (const float*)d_in[10]; a.g_post2 = (const float*)d_in[11]; a.w_up = (const float*)d_in[12]; a.w_down = (const float*)d_in[13];
    a.out = (float*)d_out; a.ws = (unsigned char*)d_ws;
    if (hipMemsetAsync((char*)d_ws + WS_BAR, 0, XCD_BAR_WORDS * 4, stream) != hipSuccess) { fprintf(stderr, "kernel_launch: memset of the barrier words failed\n"); return; }
    constexpr int NPH = 9;
    for (int li = 0; li < MK_N_LAUNCHES; ++li) {
        a.ph_lo = (MK_N_LAUNCHES == 1) ? 0 : li; a.ph_hi = (MK_N_LAUNCHES == 1) ? NPH : li + 1;
        void* kargs[] = {&a};
        const hipError_t e = hipLaunchCooperativeKernel((const void*)hybrid_fwd, dim3(grid), dim3(NTHREADS), kargs, LDS_BYTES, stream);
        if (e != hipSuccess) { fprintf(stderr, "kernel_launch: cooperative launch %d failed: %s (grid %d)\n", li, hipGetErrorString(e), grid); break; }
    }
}
```

```cpp
#include <hip/hip_runtime.h>
#include <hip/hip_cooperative_groups.h>
#include <cstdio>
#include <cstdint>
namespace cg = cooperative_groups;

#ifndef MK_N_LAUNCHES
#define MK_N_LAUNCHES 1
#endif
#ifndef FAST_GEMM
#define FAST_GEMM 1
#endif
#ifndef GEMM_SP2
#define GEMM_SP2 true
#endif
#ifndef GEMM_ALIGN
#define GEMM_ALIGN true
#endif
#ifndef UP_ALIGN
#define UP_ALIGN true
#endif
#ifndef ATTN_A_SEAM
#define ATTN_A_SEAM 1
#endif
#ifndef ATTN_A_SKEW
#define ATTN_A_SKEW 1
#endif
#ifndef FAST_ATTN_A
#define FAST_ATTN_A 1
#endif
#ifndef FAST_ATTN_B
#define FAST_ATTN_B 1
#endif

#define LAS __attribute__((address_space(3)))
typedef unsigned short bf16_t;
typedef short bf16x8 __attribute__((ext_vector_type(8)));
typedef short s16x4 __attribute__((ext_vector_type(4)));
typedef float f32x4 __attribute__((ext_vector_type(4)));
typedef float f32x16 __attribute__((ext_vector_type(16)));
typedef unsigned u32x4 __attribute__((ext_vector_type(4)));
typedef unsigned u32x2 __attribute__((ext_vector_type(2)));

constexpr int NB = 4, SEQ = 4096, T = NB * SEQ, DM = 2048, NPROJ = 4352  , FF = 8192, NUP = 3584, LAT = 512;
constexpr float EPS = 1e-6f, LOG2E = 1.4426950408889634f;
constexpr float C2A = 0.08838834764831845f * LOG2E;
constexpr float C2B = 0.07216878364870323f * LOG2E;
constexpr int NTHREADS = 512, NWAVES = 8;
constexpr int LDS_BYTES = 155648, MISC_OFF = LDS_BYTES - 64;

constexpr size_t MiB = 1u << 20;
constexpr size_t WS_SSQ = 0;
constexpr size_t WS_BAR = 128 * 1024;
constexpr size_t WS_QCTR = WS_BAR + 16 * 1024;
constexpr size_t WS_LSE = 256 * 1024;
constexpr size_t WS_COSA = 2 * MiB, WS_SINA = 3 * MiB;
constexpr size_t WS_COSB = 4 * MiB, WS_SINB = 6 * MiB;
constexpr size_t WS_BTIN = 8 * MiB;
constexpr size_t WS_BTUP = 25 * MiB;
constexpr size_t WS_BTOUT = 29 * MiB;
constexpr size_t WS_BTFU = 37 * MiB;
constexpr size_t WS_BTFD = 69 * MiB;
constexpr size_t WS_HB = 101 * MiB;
constexpr size_t WS_Y = 165 * MiB;
constexpr size_t WS_PROJ = 229 * MiB;
constexpr size_t WS_QB = 365 * MiB;
constexpr size_t WS_KVB = 413 * MiB;
constexpr size_t WS_U = 229 * MiB;
constexpr size_t WS_END = 485 * MiB;

struct Args {
    const float* x; const int* pos; const float* g_pre; const float* g_post; const float* w_in; const float* g_q; const float* g_kv;
    const float* w_uq; const float* w_ukv; const float* w_out; const float* g_pre2; const float* g_post2; const float* w_up; const float* w_down;
    float* out; unsigned char* ws; int ph_lo, ph_hi;
};

__device__ __forceinline__ unsigned cvt_pk_bf16(float lo, float hi) { unsigned r; asm volatile("v_cvt_pk_bf16_f32 %0, %1, %2" : "=v"(r) : "v"(lo), "v"(hi)); return r; }
__device__ __forceinline__ float bf_lo(unsigned w) { return __uint_as_float(w << 16); }
__device__ __forceinline__ float bf_hi(unsigned w) { return __uint_as_float(w & 0xffff0000u); }
__device__ __forceinline__ float bf2f(bf16_t h) { return __uint_as_float((unsigned)h << 16); }
__device__ __forceinline__ float wave_sum(float v) {
#pragma unroll
    for (int o = 1; o < 64; o <<= 1) v += __shfl_xor(v, o);
    return v;
}
#ifndef EPI_WT
#define EPI_WT 0
#endif
__device__ __forceinline__ void store8(bf16_t* p, const float* v) {
    u32x4 w; w.x = cvt_pk_bf16(v[0], v[1]); w.y = cvt_pk_bf16(v[2], v[3]); w.z = cvt_pk_bf16(v[4], v[5]); w.w = cvt_pk_bf16(v[6], v[7]);
#if EPI_WT
    asm volatile("global_store_dwordx4 %0, %1, off sc1\n\ts_nop 1" :: "v"(p), "v"(w) : "memory");
#else
    *(u32x4*)p = w;
#endif
}
__device__ __forceinline__ void load8f(const bf16_t* p, float* v) {
    const u32x4 w = *(const u32x4*)p;
    v[0] = bf_lo(w.x); v[1] = bf_hi(w.x); v[2] = bf_lo(w.y); v[3] = bf_hi(w.y); v[4] = bf_lo(w.z); v[5] = bf_hi(w.z); v[6] = bf_lo(w.w); v[7] = bf_hi(w.w);
}

struct Ctx {
    bf16_t *PROJ, *QB, *KVB, *Y, *U;
    float* SSQ; const float *COSA, *SINA, *COSB, *SINB;
};
enum { EK_PROJ = 0, EK_UP = 1, EK_OUT = 2, EK_FU = 3 };
__device__ __forceinline__ void rope8(float* v, const float* cs, const float* sn) {
    const f32x4 c = *(const f32x4*)cs, s = *(const f32x4*)sn;
#pragma unroll
    for (int j = 0; j < 4; ++j) { const float a = v[j], b = v[4 + j]; v[j] = a * c[j] - b * s[j]; v[4 + j] = b * c[j] + a * s[j]; }
}
template <int KIND> __device__ __forceinline__ float epi8(const Ctx& C, int row, int col, float* v, float rs_q, float rs_kv) {
    if constexpr (KIND == EK_PROJ) {
        const int pn = col >> 8; float ss = 0.f;
        if (pn < 8) {
            const int c = col & 127;
            if (c < 32) { const int i0 = 4 * (c >> 3); rope8(v, C.COSA + (size_t)row * 16 + i0, C.SINA + (size_t)row * 16 + i0); }
            if (pn < 4) {
#pragma unroll
                for (int j = 0; j < 8; ++j) v[j] *= C2A;
            }
        } else if (pn >= 12 && pn < 16) {
#pragma unroll
            for (int j = 0; j < 8; ++j) ss += v[j] * v[j];
        } else if (pn == 16) {
            const int c = col - 4096;
            if (c < 64) { const int i0 = 16 * (c >> 5) + 4 * ((c & 31) >> 3); rope8(v, C.COSB + (size_t)row * 32 + i0, C.SINB + (size_t)row * 32 + i0); }
        }
        store8(C.PROJ + (size_t)row * NPROJ + col, v);
        return ss;
    } else if constexpr (KIND == EK_UP) {
        if (col < 1536) {
            if (col >= 1024) { const int P = (col - 1024) & 63; const int i0 = 16 * (P >> 5) + 4 * ((P & 31) >> 3); rope8(v, C.COSB + (size_t)row * 32 + i0, C.SINB + (size_t)row * 32 + i0); }
            const float sc = rs_q * C2B;
#pragma unroll
            for (int j = 0; j < 8; ++j) v[j] *= sc;
            store8(C.QB + (size_t)row * 1536 + col, v);
        } else {
#pragma unroll
            for (int j = 0; j < 8; ++j) v[j] *= rs_kv;
            store8(C.KVB + (size_t)row * 2048 + (col - 1536), v);
        }
        return 0.f;
    } else if constexpr (KIND == EK_OUT) {
        store8(C.Y + (size_t)row * DM + col, v); return 0.f;
    } else {
#pragma unroll
        for (int j = 0; j < 8; ++j) { const float r = fmaxf(v[j], 0.f); v[j] = r * r; }
        store8(C.U + (size_t)row * FF + col, v); return 0.f;
    }
}
__device__ __forceinline__ float rs_from_ssq(float ss) { return 1.0f / sqrtf(ss * (1.0f / LAT) + EPS); }

struct GemmDesc { const bf16_t* A; const bf16_t* Bt; int M, N, K, lda; int split_pn; int aoff0, aoff1;
    __device__ __forceinline__ int aoff(int pn) const { return pn < split_pn ? aoff0 : aoff1; } };
template <int KIND> __device__ void naive_gemm(const GemmDesc g, const Ctx& C) {
    const long total = (long)g.M * (g.N / 8);
    for (long idx = (long)blockIdx.x * NTHREADS + threadIdx.x; idx < total; idx += (long)gridDim.x * NTHREADS) {
        const int row = (int)(idx % g.M), col = (int)(idx / g.M) * 8;
        const bf16_t* a = (const bf16_t*)((const char*)g.A + g.aoff(col >> 8)) + (size_t)row * g.lda;
        const bf16_t* b = g.Bt + (size_t)col * g.K;
        float acc[8] = {0.f, 0.f, 0.f, 0.f, 0.f, 0.f, 0.f, 0.f};
        for (int k = 0; k < g.K; k += 8) {
            float av[8]; load8f(a + k, av);
#pragma unroll
            for (int j = 0; j < 8; ++j) { float bv[8]; load8f(b + (size_t)j * g.K + k, bv);
#pragma unroll
                for (int e = 0; e < 8; ++e) acc[j] += av[e] * bv[e]; }
        }
        float rq = 0.f, rkv = 0.f;
        if constexpr (KIND == EK_UP) { rq = rs_from_ssq(C.SSQ[row * 2]); rkv = rs_from_ssq(C.SSQ[row * 2 + 1]); }
        const float ss = epi8<KIND>(C, row, col, acc, rq, rkv);
        if constexpr (KIND == EK_PROJ) { const int pn = col >> 8; if (pn >= 12 && pn < 16) atomicAdd(C.SSQ + row * 2 + (pn >= 14 ? 1 : 0), ss); }
    }
}

namespace pg8 {
#define PG8_LAS __attribute__((address_space(3)))
constexpr int BM = 256, BK = 64, HALF = 128, HTB = HALF * BK * 2  , STAGE_BYTES = 8 * HTB, NXCD = 8, WGM = 4;
__host__ __device__ __forceinline__ int lds_byte(int r, int c) { const int st = (r >> 4) * 2 + (c >> 5), rr = r & 15, cc = c & 31, ob = rr * 64 + cc * 2; return st * 1024 + (ob ^ (((ob >> 9) & 1) << 5)); }
__host__ __device__ __forceinline__ void stage_rc(int b, int& R, int& C) { const int st = b / 1024, sb = b % 1024, swz = sb ^ (((sb >> 9) & 1) << 5); R = (st >> 1) * 16 + swz / 64; C = (st & 1) * 32 + (swz % 64) / 2; }
__host__ __device__ __forceinline__ int perm32(int rho) { const int n = rho >> 4, i = rho & 15; return 8 * (i >> 2) + 4 * n + (i & 3); }
struct Unit { int pm, pn; };
typedef GemmDesc Gemm;
struct StaticOrder {
    int nM, nN, nwg, G, c;
    __host__ __device__ void init(int M, int N, int G_, int c_) { nM = M / BM; nN = N / BM; nwg = nM * nN; G = G_; c = c_; }
    __host__ __device__ bool next(int i, Unit& u) const {
        const long L = (long)i * G + c; if (L >= nwg) return false;
        int wgid = (int)L; { const int q = nwg / NXCD, r = nwg % NXCD, xcd = wgid % NXCD, off = wgid / NXCD; wgid = (xcd < r ? xcd * (q + 1) : r * (q + 1) + (xcd - r) * q) + off; }
        const int nig = WGM * nN, gid = wgid / nig, fm = gid * WGM, gsz = (nM - fm) < WGM ? (nM - fm) : WGM;
        u.pm = fm + ((wgid % nig) % gsz); u.pn = (wgid % nig) / gsz; return true;
    }
    __device__ __forceinline__ void a_ready(const Unit&) const {}
    __device__ __forceinline__ void done(const Unit&) const {}
};
template <int KIND> struct EpiK {
    static constexpr bool PERM = true, AFTER_DRAIN = false;
    Ctx C;
    __device__ __forceinline__ void operator()(const f32x4 (&acc)[2][2][4][2], const Unit& u, int wr, int wc, int fr, int fq) const {
#pragma unroll
        for (int ai = 0; ai < 2; ++ai)
#pragma unroll
            for (int m = 0; m < 4; ++m) {
                const int row = u.pm * BM + ai * HALF + wr * 64 + m * 16 + fr;
                float rq = 0.f, rkv = 0.f, ssum = 0.f;
                if constexpr (KIND == EK_UP) { if (u.pn < 6) rq = rs_from_ssq(C.SSQ[row * 2]); else rkv = rs_from_ssq(C.SSQ[row * 2 + 1]); }
#pragma unroll
                for (int bj = 0; bj < 2; ++bj) {
                    const int col = u.pn * BM + bj * HALF + wc * 32 + fq * 8;
                    float v[8] = {acc[ai][bj][m][0][0], acc[ai][bj][m][0][1], acc[ai][bj][m][0][2], acc[ai][bj][m][0][3], acc[ai][bj][m][1][0], acc[ai][bj][m][1][1], acc[ai][bj][m][1][2], acc[ai][bj][m][1][3]};
                    ssum += epi8<KIND>(C, row, col, v, rq, rkv);
                }
                if constexpr (KIND == EK_PROJ) {
                    if (u.pn >= 12 && u.pn < 16) { ssum += __shfl_xor(ssum, 16); ssum += __shfl_xor(ssum, 32); if (fq == 0) atomicAdd(C.SSQ + row * 2 + (u.pn >= 14 ? 1 : 0), ssum); }
                }
            }
    }
};
template <class Epi, class Sched, bool ALIGN_EPI = false, bool SP2 = false>
__device__ __forceinline__ void gemm_phase(PG8_LAS unsigned char* lds, const Gemm g, const Sched& S, const Epi& E) {
    const int tid = threadIdx.x, wid = __builtin_amdgcn_readfirstlane(tid >> 6), lane = tid & 63, wr = wid >> 2, wc = wid & 3, fr = lane & 15, fq = lane >> 4;
    const int K = g.K, nt = K / BK;
    unsigned voffA[2], voffB[2];
#pragma unroll
    for (int i = 0; i < 2; ++i) { int R, C; stage_rc(tid * 16 + i * 8192, R, C); const int Rb = Epi::PERM ? ((R & ~31) + perm32(R & 31)) : R;
        voffA[i] = (unsigned)(R * g.lda + C) * 2u; voffB[i] = (unsigned)(Rb * K + C) * 2u; }
    const size_t kstep = (size_t)(BK * 2);
    const size_t hstepA = (size_t)HALF * g.lda * 2, hstepB = (size_t)HALF * K * 2;
    const size_t tstepA = 2 * hstepA, tstepB = 2 * hstepB;
    const unsigned ldsw = (unsigned)wid * 1024u;
    const int aoff = lds_byte(wr * 64 + fr, fq * 8), boff = lds_byte(wc * 32 + fr, fq * 8);
#define PG8_SA(b, h) (((b) * 2 + (h)) * HTB)
#define PG8_SB(b, h) ((4 + (b) * 2 + (h)) * HTB)
#define PG8_STAGE(bufoff, gbase, voff) do { _Pragma("unroll") for (int _i = 0; _i < 2; ++_i) \
        __builtin_amdgcn_global_load_lds((const unsigned*)((const char*)(gbase) + (voff)[_i]), (PG8_LAS unsigned*)(lds + (bufoff) + ldsw + _i * 8192), 16, 0, 0); } while (0)
#define PG8_LDA(dst, b, h) do { _Pragma("unroll") for (int m = 0; m < 4; ++m) _Pragma("unroll") for (int k = 0; k < 2; ++k) dst[m][k] = *(const PG8_LAS bf16x8*)(lds + PG8_SA(b, h) + aoff + m * 2048 + k * 1024); } while (0)
#define PG8_LDB(dst, b, h) do { _Pragma("unroll") for (int n = 0; n < 2; ++n) _Pragma("unroll") for (int k = 0; k < 2; ++k) dst[n][k] = *(const PG8_LAS bf16x8*)(lds + PG8_SB(b, h) + boff + n * 2048 + k * 1024); } while (0)
#define PG8_MMA(ai, bj, At, Bt) do { __builtin_amdgcn_s_setprio(1); _Pragma("unroll") for (int m = 0; m < 4; ++m) _Pragma("unroll") for (int n = 0; n < 2; ++n) _Pragma("unroll") for (int k = 0; k < 2; ++k) \
        acc[ai][bj][m][n] = __builtin_amdgcn_mfma_f32_16x16x32_bf16(Bt[n][k], At[m][k], acc[ai][bj][m][n], 0, 0, 0); __builtin_amdgcn_s_setprio(0); } while (0)
#define PG8_WAIT_V(n) asm volatile("s_waitcnt vmcnt(" #n ")" ::: "memory")
#define PG8_WAIT_L(n) asm volatile("s_waitcnt lgkmcnt(" #n ")" ::: "memory")
#define PG8_BAR __builtin_amdgcn_s_barrier()
#define PG8_SCHED __builtin_amdgcn_sched_barrier(0)
    Unit cur, nxt; int ui = 0;
    if (!S.next(0, cur)) return;
    f32x4 acc[2][2][4][2];
#pragma unroll
    for (int a = 0; a < 2; ++a)
#pragma unroll
        for (int b = 0; b < 2; ++b)
#pragma unroll
            for (int m = 0; m < 4; ++m)
#pragma unroll
                for (int n = 0; n < 2; ++n) acc[a][b][m][n] = (f32x4){0.f, 0.f, 0.f, 0.f};
    bf16x8 At[4][2], B0[2][2], B1[2][2];
    const char* cA = (const char*)g.A + g.aoff(cur.pn) + (size_t)cur.pm * tstepA; const char* cB = (const char*)g.Bt + (size_t)cur.pn * tstepB;
    S.a_ready(cur);
    if constexpr (SP2) {
        PG8_STAGE(PG8_SB(0, 0), cB, voffB); PG8_STAGE(PG8_SB(0, 1), cB + hstepB, voffB); PG8_STAGE(PG8_SA(0, 0), cA, voffA); PG8_STAGE(PG8_SA(0, 1), cA + hstepA, voffA);
        if (wr == 1) PG8_BAR;
        PG8_WAIT_V(2); PG8_BAR;
        PG8_STAGE(PG8_SB(1, 0), cB + kstep, voffB); PG8_STAGE(PG8_SA(1, 0), cA + kstep, voffA); PG8_STAGE(PG8_SB(1, 1), cB + hstepB + kstep, voffB);
        PG8_WAIT_V(6); PG8_BAR;
    } else {
        PG8_STAGE(PG8_SB(0, 0), cB, voffB); PG8_STAGE(PG8_SA(0, 0), cA, voffA); PG8_STAGE(PG8_SB(0, 1), cB + hstepB, voffB); PG8_STAGE(PG8_SA(0, 1), cA + hstepA, voffA);
        if (wr == 1) PG8_BAR;
        PG8_WAIT_V(4); PG8_BAR;
        PG8_STAGE(PG8_SB(1, 0), cB + kstep, voffB); PG8_STAGE(PG8_SA(1, 0), cA + kstep, voffA); PG8_STAGE(PG8_SB(1, 1), cB + hstepB + kstep, voffB);
        PG8_WAIT_V(6); PG8_BAR;
    }
    for (;;) {
        const bool has_next = S.next(ui + 1, nxt);
        const char* nA = has_next ? (const char*)g.A + g.aoff(nxt.pn) + (size_t)nxt.pm * tstepA : cA; const char* nB = has_next ? (const char*)g.Bt + (size_t)nxt.pn * tstepB : cB;
        for (int t = 0; t < nt; t += 2) {
            const bool last = (t == nt - 2);
            const char* a1 = cA + (size_t)(t + 1) * kstep;
            const char* a2 = last ? nA : cA + (size_t)(t + 2) * kstep; const char* b2 = last ? nB : cB + (size_t)(t + 2) * kstep;
            const char* a3 = a2 + kstep; const char* b3 = b2 + kstep;
            if (last && has_next) S.a_ready(nxt);
            if constexpr (SP2) {
            PG8_LDB(B0, 0, 0); PG8_LDB(B1, 0, 1); PG8_SCHED; PG8_LDA(At, 0, 0); PG8_STAGE(PG8_SA(1, 1), a1 + hstepA, voffA);
            PG8_WAIT_V(8); PG8_WAIT_L(0); PG8_BAR; PG8_MMA(0, 0, At, B0); PG8_MMA(0, 1, At, B1); PG8_BAR; PG8_SCHED;
            PG8_LDA(At, 0, 1); PG8_STAGE(PG8_SB(0, 0), b2, voffB); PG8_STAGE(PG8_SB(0, 1), b2 + hstepB, voffB); PG8_STAGE(PG8_SA(0, 0), a2, voffA);
            PG8_WAIT_V(8); PG8_WAIT_L(0); PG8_BAR; PG8_MMA(1, 0, At, B0); PG8_MMA(1, 1, At, B1); PG8_BAR; PG8_SCHED;
            PG8_LDB(B0, 1, 0); PG8_LDB(B1, 1, 1); PG8_SCHED; PG8_LDA(At, 1, 0); PG8_STAGE(PG8_SA(0, 1), a2 + hstepA, voffA);
            PG8_WAIT_V(8); PG8_WAIT_L(0); PG8_BAR; PG8_MMA(0, 0, At, B0); PG8_MMA(0, 1, At, B1); PG8_BAR; PG8_SCHED;
            PG8_LDA(At, 1, 1); PG8_STAGE(PG8_SB(1, 0), b3, voffB); PG8_STAGE(PG8_SB(1, 1), b3 + hstepB, voffB); PG8_STAGE(PG8_SA(1, 0), a3, voffA);
            PG8_WAIT_V(8); PG8_WAIT_L(0); PG8_BAR; PG8_MMA(1, 0, At, B0); PG8_MMA(1, 1, At, B1); PG8_BAR; PG8_SCHED;
            } else {
            PG8_LDB(B0, 0, 0); PG8_SCHED; PG8_LDA(At, 0, 0); PG8_STAGE(PG8_SA(1, 1), a1 + hstepA, voffA);
            PG8_WAIT_L(8); PG8_BAR; PG8_WAIT_L(0); PG8_MMA(0, 0, At, B0); PG8_BAR; PG8_SCHED;
            PG8_LDB(B1, 0, 1); PG8_STAGE(PG8_SB(0, 0), b2, voffB);
            PG8_BAR; PG8_WAIT_L(0); PG8_MMA(0, 1, At, B1); PG8_BAR;
            PG8_LDA(At, 0, 1); PG8_STAGE(PG8_SA(0, 0), a2, voffA);
            PG8_BAR; PG8_WAIT_L(0); PG8_MMA(1, 0, At, B0); PG8_BAR; PG8_SCHED;
            PG8_STAGE(PG8_SB(0, 1), b2 + hstepB, voffB);
            PG8_WAIT_V(6); PG8_BAR; PG8_MMA(1, 1, At, B1); PG8_BAR;
            PG8_LDB(B0, 1, 0); PG8_SCHED; PG8_LDA(At, 1, 0); PG8_STAGE(PG8_SA(0, 1), a2 + hstepA, voffA);
            PG8_WAIT_L(8); PG8_BAR; PG8_WAIT_L(0); PG8_MMA(0, 0, At, B0); PG8_BAR; PG8_SCHED;
            PG8_LDB(B1, 1, 1); PG8_STAGE(PG8_SB(1, 0), b3, voffB);
            PG8_BAR; PG8_WAIT_L(0); PG8_MMA(0, 1, At, B1); PG8_BAR;
            PG8_LDA(At, 1, 1); PG8_STAGE(PG8_SA(1, 0), a3, voffA);
            PG8_BAR; PG8_WAIT_L(0); PG8_MMA(1, 0, At, B0); PG8_BAR; PG8_SCHED;
            PG8_STAGE(PG8_SB(1, 1), b3 + hstepB, voffB);
            PG8_WAIT_V(6); PG8_BAR; PG8_MMA(1, 1, At, B1); PG8_BAR;
            }
        }
        if constexpr (ALIGN_EPI) { if (wr == 0) PG8_BAR; }
        if constexpr (!Epi::AFTER_DRAIN) { E(acc, cur, wr, wc, fr, fq); S.done(cur); }
        if (!has_next) break;
#pragma unroll
        for (int a = 0; a < 2; ++a)
#pragma unroll
            for (int b = 0; b < 2; ++b)
#pragma unroll
                for (int m = 0; m < 4; ++m)
#pragma unroll
                    for (int n = 0; n < 2; ++n) acc[a][b][m][n] = (f32x4){0.f, 0.f, 0.f, 0.f};
        cur = nxt; cA = nA; cB = nB; ++ui;
        if constexpr (ALIGN_EPI) { if (wr == 1) PG8_BAR; }
    }
    PG8_WAIT_V(0);
    if constexpr (!ALIGN_EPI) { if (wr == 0) PG8_BAR; }
    PG8_BAR;
    if constexpr (Epi::AFTER_DRAIN) { E.fused(acc, cur, wr, wc, fr, fq, lds, wid, lane); S.done(cur); }
#undef PG8_SA
#undef PG8_SB
#undef PG8_STAGE
#undef PG8_LDA
#undef PG8_LDB
#undef PG8_MMA
#undef PG8_WAIT_V
#undef PG8_WAIT_L
#undef PG8_BAR
#undef PG8_SCHED
}
}

__device__ __forceinline__ int permA(int p) { return 16 * ((p >> 2) & 1) + 4 * (p >> 3) + (p & 3); }
__device__ __forceinline__ int permB(int P) { const int g = P >> 5, p = P & 31; return 32 * ((p >> 2) & 1) + 16 * g + 4 * (p >> 3) + (p & 3); }
struct TrItem { const float* W; const float* gain; bf16_t* WT; int N, K, k0, n0, src, n0src; bool fast; };
__device__ __forceinline__ TrItem tr_decode(const Args& a, int it, int lane) {
    constexpr int I_IN = (NPROJ / 64) * (DM / 64), I_UP = (NUP / 64) * (LAT / 64), I_OUT = (DM / 64) * (DM / 64), I_FU = (FF / 64) * (DM / 64);
    unsigned char* ws = a.ws; TrItem P; int r = it; P.gain = nullptr;
    if (r < I_IN) { const int nb = r % (NPROJ / 64), kb = r / (NPROJ / 64), n = nb * 64 + lane; int src;
        if (n < 2048) { const int c = n & 127; src = (n & ~127) + (c < 32 ? permA(c) : c); } else if (n < 4096) src = n; else { const int Pp = n - 4096; src = Pp < 64 ? 4096 + permB(Pp) : -1; }
        P.W = a.w_in; P.N = 4160; P.k0 = kb * 64; P.src = src; P.WT = (bf16_t*)(ws + WS_BTIN); P.K = DM; P.n0 = nb * 64; }
    else if ((r -= I_IN) < I_UP) { const int nb = r % (NUP / 64), kb = r / (NUP / 64), n = nb * 64 + lane; P.k0 = kb * 64; P.WT = (bf16_t*)(ws + WS_BTUP); P.K = LAT; P.n0 = nb * 64;
        if (n < 1536) { int src; if (n < 1024) src = (n >> 7) * 192 + (n & 127); else { const int q = n - 1024; src = (q >> 6) * 192 + 128 + permB(q & 63); } P.W = a.w_uq; P.N = 1536; P.src = src; P.gain = a.g_q; }
        else { P.W = a.w_ukv; P.N = 2048; P.src = n - 1536; P.gain = a.g_kv; } }
    else if ((r -= I_UP) < I_OUT) { const int nb = r % (DM / 64), kb = r / (DM / 64); P.W = a.w_out; P.N = DM; P.k0 = kb * 64; P.src = nb * 64 + lane; P.WT = (bf16_t*)(ws + WS_BTOUT); P.K = DM; P.n0 = nb * 64; }
    else if ((r -= I_OUT) < I_FU) { const int nb = r % (FF / 64), kb = r / (FF / 64); P.W = a.w_up; P.N = FF; P.k0 = kb * 64; P.src = nb * 64 + lane; P.WT = (bf16_t*)(ws + WS_BTFU); P.K = DM; P.n0 = nb * 64; }
    else { r -= I_FU; const int nb = r % (DM / 64), kb = r / (DM / 64); P.W = a.w_down; P.N = DM; P.k0 = kb * 64; P.src = nb * 64 + lane; P.WT = (bf16_t*)(ws + WS_BTFD); P.K = FF; P.n0 = nb * 64; }
    P.n0src = __builtin_amdgcn_readfirstlane(P.src);
    P.fast = !P.gain && __all(P.src == P.n0src + lane);
    return P;
}
__device__ __forceinline__ void tr_load(const TrItem& P, float (&v)[64], int lane) {
    if (P.fast) { const int c4 = lane & 15, kq = lane >> 4;
#pragma unroll
        for (int i = 0; i < 16; ++i) { const f32x4 x = *(const f32x4*)(P.W + (size_t)(P.k0 + kq + 4 * i) * P.N + P.n0src + 4 * c4); v[4 * i] = x.x; v[4 * i + 1] = x.y; v[4 * i + 2] = x.z; v[4 * i + 3] = x.w; }
    } else {
#pragma unroll
        for (int kk = 0; kk < 64; ++kk) v[kk] = P.src >= 0 ? P.W[(size_t)(P.k0 + kk) * P.N + P.src] : 0.f;
    }
}
__device__ __forceinline__ void tr_to_lds(const TrItem& P, const float (&v)[64], LAS float* scr, int lane) {
    if (P.fast) { const int c4 = lane & 15, kq = lane >> 4;
#pragma unroll
        for (int i = 0; i < 16; ++i) { LAS float* d = scr + (kq + 4 * i) * 65 + 4 * c4; d[0] = v[4 * i]; d[1] = v[4 * i + 1]; d[2] = v[4 * i + 2]; d[3] = v[4 * i + 3]; }
    } else {
#pragma unroll
        for (int kk = 0; kk < 64; ++kk) scr[kk * 65 + lane] = P.gain ? v[kk] * P.gain[P.k0 + kk] : v[kk];
    }
    asm volatile("s_waitcnt lgkmcnt(0)" ::: "memory");
}
__device__ __forceinline__ void tr_store(const TrItem& P, LAS float* scr, int lane) {
    const int c = lane & 7;
#pragma unroll
    for (int j = 0; j < 8; ++j) { const int n = (lane >> 3) + 8 * j; const LAS float* s = scr + (8 * c) * 65 + n;
        u32x4 o; o.x = cvt_pk_bf16(s[0 * 65], s[1 * 65]); o.y = cvt_pk_bf16(s[2 * 65], s[3 * 65]); o.z = cvt_pk_bf16(s[4 * 65], s[5 * 65]); o.w = cvt_pk_bf16(s[6 * 65], s[7 * 65]);
        *(u32x4*)(P.WT + (size_t)(P.n0 + n) * P.K + P.k0 + 8 * c) = o; }
    asm volatile("s_waitcnt lgkmcnt(0)" ::: "memory");
}
#ifndef PROBE_T
#define PROBE_T -1
#endif
#define TB(id) unsigned long long tb_##id = 0; if (PROBE_T == (id)) tb_##id = __builtin_amdgcn_s_memrealtime();
#define TE(id) if (PROBE_T == (id)) { __syncthreads(); const unsigned long long t1_ = __builtin_amdgcn_s_memrealtime(), dt_ = t1_ - tb_##id; while (__builtin_amdgcn_s_memrealtime() - t1_ < dt_) __builtin_amdgcn_s_sleep(4); }
__device__ __forceinline__ void p0_prologue(const Args& a, LAS unsigned char* lds) {
    unsigned char* ws = a.ws;
    const int tid = threadIdx.x, lane = tid & 63, wave = tid >> 6;
    const int gw = blockIdx.x * NWAVES + wave, NGW = gridDim.x * NWAVES;
    const long gt = (long)blockIdx.x * NTHREADS + tid, NGT = (long)gridDim.x * NTHREADS;
    TB(1) { float* ssq = (float*)(ws + WS_SSQ); for (long i = gt; i < (long)T * 2; i += NGT) ssq[i] = 0.f; }
    { float* ca = (float*)(ws + WS_COSA); float* sa = (float*)(ws + WS_SINA); float* cb = (float*)(ws + WS_COSB); float* sb = (float*)(ws + WS_SINB);
      const float l2t = 18.931568569324174f;
      for (long i = gt; i < (long)T * 32; i += NGT) { const int t = (int)(i >> 5), f = (int)(i & 31); const float p = (float)a.pos[t];
          { const float inv = exp2f(-(float)(2 * f) * (1.0f / 64.0f) * l2t); const float ang = p * inv; cb[i] = cosf(ang); sb[i] = sinf(ang); }
          if (f < 16) { const float inv = exp2f(-(float)(2 * f) * (1.0f / 32.0f) * l2t); const float ang = p * inv; ca[t * 16 + f] = cosf(ang); sa[t * 16 + f] = sinf(ang); } } }
    TE(1)
    TB(2) { bf16_t* HB = (bf16_t*)(ws + WS_HB);
      int m = gw;
      if (m < T) { f32x4 v[8];
#pragma unroll
          for (int j = 0; j < 8; ++j) v[j] = ((const f32x4*)(a.x + (size_t)m * DM) + lane)[64 * j];
          for (;;) { const int mn = m + NGW; const bool more = mn < T; f32x4 vn[8];
              if (more) {
#pragma unroll
                  for (int j = 0; j < 8; ++j) vn[j] = ((const f32x4*)(a.x + (size_t)mn * DM) + lane)[64 * j]; }
              float s = 0.f;
#pragma unroll
              for (int j = 0; j < 8; ++j) s += (v[j].x * v[j].x + v[j].y * v[j].y) + (v[j].z * v[j].z + v[j].w * v[j].w);
              const float rs = 1.0f / sqrtf(wave_sum(s) * (1.0f / DM) + EPS);
              u32x2* o = (u32x2*)(HB + (size_t)m * DM) + lane;
#pragma unroll
              for (int j = 0; j < 8; ++j) { const f32x4 g = *((const f32x4*)a.g_pre + lane + 64 * j); u32x2 w; w.x = cvt_pk_bf16(v[j].x * rs * g.x, v[j].y * rs * g.y); w.y = cvt_pk_bf16(v[j].z * rs * g.z, v[j].w * rs * g.w); o[64 * j] = w; }
              if (!more) break;
#pragma unroll
              for (int j = 0; j < 8; ++j) v[j] = vn[j];
              m = mn; } } }
    TE(2)
    TB(3) { LAS float* scr = (LAS float*)(lds + wave * 16640);
      constexpr int NITEMS = (NPROJ / 64) * (DM / 64) + (NUP / 64) * (LAT / 64) + (DM / 64) * (DM / 64) + (FF / 64) * (DM / 64) + (DM / 64) * (FF / 64);
      int it = gw;
      if (it < NITEMS) {
          float v[64]; TrItem P = tr_decode(a, it, lane); tr_load(P, v, lane);
          for (;;) {
              tr_to_lds(P, v, scr, lane);
              const int itn = it + NGW; const bool more = itn < NITEMS; TrItem Pn = P;
              if (more) { Pn = tr_decode(a, itn, lane); tr_load(Pn, v, lane); }
              tr_store(P, scr, lane);
              if (!more) break;
              P = Pn; it = itn;
          }
      } }
    TE(3)
}

__device__ __forceinline__ void row_pass1(const Args& a) {
    const int lane = threadIdx.x & 63, gw = blockIdx.x * NWAVES + (threadIdx.x >> 6), NGW = gridDim.x * NWAVES;
    const bf16_t* Y = (const bf16_t*)(a.ws + WS_Y); bf16_t* HB = (bf16_t*)(a.ws + WS_HB);
    const bool aff_ = (gridDim.x == 256);
    const int rbase_ = aff_ ? (int)(blockIdx.x & 7) * 2048 + (int)(blockIdx.x >> 3) * 8 + (int)(threadIdx.x >> 6) : gw;
    const int rstep_ = aff_ ? 256 : NGW, rend_ = aff_ ? (int)(blockIdx.x & 7) * 2048 + 2048 : T;
    int m = rbase_; if (m >= rend_) return;
    f32x4 xv[8]; u32x2 yw[8];
#pragma unroll
    for (int j = 0; j < 8; ++j) { xv[j] = ((const f32x4*)(a.x + (size_t)m * DM) + lane)[64 * j]; yw[j] = ((const u32x2*)(Y + (size_t)m * DM) + lane)[64 * j]; }
    for (;;) {
        const int mn = m + rstep_; const bool more = mn < rend_; f32x4 xn[8]; u32x2 yn[8];
        if (more) {
#pragma unroll
            for (int j = 0; j < 8; ++j) { xn[j] = ((const f32x4*)(a.x + (size_t)mn * DM) + lane)[64 * j]; yn[j] = ((const u32x2*)(Y + (size_t)mn * DM) + lane)[64 * j]; } }
        f32x4 yv[8]; float s = 0.f;
#pragma unroll
        for (int j = 0; j < 8; ++j) { yv[j] = (f32x4){bf_lo(yw[j].x), bf_hi(yw[j].x), bf_lo(yw[j].y), bf_hi(yw[j].y)};
            s += (yv[j].x * yv[j].x + yv[j].y * yv[j].y) + (yv[j].z * yv[j].z + yv[j].w * yv[j].w); }
        const float rs = 1.0f / sqrtf(wave_sum(s) * (1.0f / DM) + EPS); float s2 = 0.f;
#pragma unroll
        for (int j = 0; j < 8; ++j) { const f32x4 g = *((const f32x4*)a.g_post + lane + 64 * j); xv[j] = xv[j] + yv[j] * rs * g;
            s2 += (xv[j].x * xv[j].x + xv[j].y * xv[j].y) + (xv[j].z * xv[j].z + xv[j].w * xv[j].w); }
        const float rs2 = 1.0f / sqrtf(wave_sum(s2) * (1.0f / DM) + EPS);
        u32x2* hr = (u32x2*)(HB + (size_t)m * DM) + lane;
#pragma unroll
        for (int j = 0; j < 8; ++j) { const f32x4 g = *((const f32x4*)a.g_pre2 + lane + 64 * j);
            u32x2 w; w.x = cvt_pk_bf16(xv[j].x * rs2 * g.x, xv[j].y * rs2 * g.y); w.y = cvt_pk_bf16(xv[j].z * rs2 * g.z, xv[j].w * rs2 * g.w); hr[64 * j] = w; }
        if (!more) break;
#pragma unroll
        for (int j = 0; j < 8; ++j) { xv[j] = xn[j]; yw[j] = yn[j]; }
        m = mn;
    }
}
__device__ __forceinline__ void row_pass2(const Args& a) {
    const int lane = threadIdx.x & 63, gw = blockIdx.x * NWAVES + (threadIdx.x >> 6), NGW = gridDim.x * NWAVES;
    const bf16_t* Y = (const bf16_t*)(a.ws + WS_Y); const bf16_t* Z = (const bf16_t*)(a.ws + WS_HB);
    const bool aff_ = (gridDim.x == 256);
    const int rbase_ = aff_ ? (int)(blockIdx.x & 7) * 2048 + (int)(blockIdx.x >> 3) * 8 + (int)(threadIdx.x >> 6) : gw;
    const int rstep_ = aff_ ? 256 : NGW, rend_ = aff_ ? (int)(blockIdx.x & 7) * 2048 + 2048 : T;
    int m = rbase_; if (m >= rend_) return;
    f32x4 xv[8]; u32x2 yw[8], zw[8];
#pragma unroll
    for (int j = 0; j < 8; ++j) { xv[j] = ((const f32x4*)(a.x + (size_t)m * DM) + lane)[64 * j]; yw[j] = ((const u32x2*)(Y + (size_t)m * DM) + lane)[64 * j]; zw[j] = ((const u32x2*)(Z + (size_t)m * DM) + lane)[64 * j]; }
    for (;;) {
        const int mn = m + rstep_; const bool more = mn < rend_; f32x4 xn[8]; u32x2 yn[8], zn[8];
        if (more) {
#pragma unroll
            for (int j = 0; j < 8; ++j) { xn[j] = ((const f32x4*)(a.x + (size_t)mn * DM) + lane)[64 * j]; yn[j] = ((const u32x2*)(Y + (size_t)mn * DM) + lane)[64 * j]; zn[j] = ((const u32x2*)(Z + (size_t)mn * DM) + lane)[64 * j]; } }
        float s = 0.f, s2 = 0.f;
#pragma unroll
        for (int j = 0; j < 8; ++j) { const float y0 = bf_lo(yw[j].x), y1 = bf_hi(yw[j].x), y2 = bf_lo(yw[j].y), y3 = bf_hi(yw[j].y); s += (y0 * y0 + y1 * y1) + (y2 * y2 + y3 * y3);
            const float z0 = bf_lo(zw[j].x), z1 = bf_hi(zw[j].x), z2 = bf_lo(zw[j].y), z3 = bf_hi(zw[j].y); s2 += (z0 * z0 + z1 * z1) + (z2 * z2 + z3 * z3); }
        const float rs = 1.0f / sqrtf(wave_sum(s) * (1.0f / DM) + EPS), rs2 = 1.0f / sqrtf(wave_sum(s2) * (1.0f / DM) + EPS);
        f32x4* orow = (f32x4*)(a.out + (size_t)m * DM) + lane;
#pragma unroll
        for (int j = 0; j < 8; ++j) { const f32x4 g1 = *((const f32x4*)a.g_post + lane + 64 * j), g2 = *((const f32x4*)a.g_post2 + lane + 64 * j);
            const f32x4 yv = (f32x4){bf_lo(yw[j].x), bf_hi(yw[j].x), bf_lo(yw[j].y), bf_hi(yw[j].y)}, zv = (f32x4){bf_lo(zw[j].x), bf_hi(zw[j].x), bf_lo(zw[j].y), bf_hi(zw[j].y)};
            const f32x4 x1 = xv[j] + yv * rs * g1;
            __builtin_nontemporal_store(x1 + zv * rs2 * g2, &orow[64 * j]); }
        if (!more) break;
#pragma unroll
        for (int j = 0; j < 8; ++j) { xv[j] = xn[j]; yw[j] = yn[j]; zw[j] = zn[j]; }
        m = mn;
    }
}

__device__ void naive_attn_a(const Args& a) {
    const int lane = threadIdx.x & 63, gw = blockIdx.x * NWAVES + (threadIdx.x >> 6), NGW = gridDim.x * NWAVES;
    const bf16_t* PROJ = (const bf16_t*)(a.ws + WS_PROJ); bf16_t* MIX = (bf16_t*)(a.ws + WS_HB);
    for (int it = gw; it < T * 8; it += NGW) {
        const int t = it >> 3, hh = it & 7, s = t & (SEQ - 1);
        const unsigned qw = *(const unsigned*)(PROJ + (size_t)t * NPROJ + hh * 128 + 2 * lane); const float q0 = bf_lo(qw), q1 = bf_hi(qw);
        float m = -1e30f, l = 0.f, o0 = 0.f, o1 = 0.f;
        for (int c = 0; c < 3; ++c) { const int d = c == 0 ? 1 : (c == 1 ? 4 : 16);
            for (int k = 0; k <= 128; ++k) { if (s - k * d < 0) break; const size_t tk = (size_t)(t - k * d);
                const unsigned kw = *(const unsigned*)(PROJ + tk * NPROJ + 1024 + hh * 128 + 2 * lane), vw = *(const unsigned*)(PROJ + tk * NPROJ + 2048 + hh * 128 + 2 * lane);
                const float sc = wave_sum(q0 * bf_lo(kw) + q1 * bf_hi(kw));
                const float mn = fmaxf(m, sc), al = exp2f(m - mn), p = exp2f(sc - mn);
                l = l * al + p; o0 = o0 * al + p * bf_lo(vw); o1 = o1 * al + p * bf_hi(vw); m = mn; } }
        const float il = 1.0f / l;
        *(unsigned*)(MIX + (size_t)t * DM + hh * 128 + 2 * lane) = cvt_pk_bf16(o0 * il, o1 * il);
    }
}
__device__ void naive_attn_b(const Args& a) {
    const int lane = threadIdx.x & 63, gw = blockIdx.x * NWAVES + (threadIdx.x >> 6), NGW = gridDim.x * NWAVES;
    const bf16_t* PROJ = (const bf16_t*)(a.ws + WS_PROJ); const bf16_t* QB = (const bf16_t*)(a.ws + WS_QB); const bf16_t* KVB = (const bf16_t*)(a.ws + WS_KVB); bf16_t* MIX = (bf16_t*)(a.ws + WS_HB);
    for (int it = gw; it < T * 8; it += NGW) {
        const int t = it >> 3, hh = it & 7, s = t & (SEQ - 1), t0 = t - s;
        const unsigned qw = *(const unsigned*)(QB + (size_t)t * 1536 + hh * 128 + 2 * lane); const float q0 = bf_lo(qw), q1 = bf_hi(qw), q2 = bf2f(QB[(size_t)t * 1536 + 1024 + hh * 64 + lane]);
        float m = -1e30f, l = 0.f, o0 = 0.f, o1 = 0.f;
        for (int j = 0; j <= s; ++j) { const size_t tk = (size_t)(t0 + j);
            const unsigned kw = *(const unsigned*)(KVB + tk * 2048 + hh * 256 + 2 * lane), vw = *(const unsigned*)(KVB + tk * 2048 + hh * 256 + 128 + 2 * lane);
            const float kr = bf2f(PROJ[tk * NPROJ + 4096 + lane]);
            const float sc = wave_sum(q0 * bf_lo(kw) + q1 * bf_hi(kw) + q2 * kr);
            const float mn = fmaxf(m, sc), al = exp2f(m - mn), p = exp2f(sc - mn);
            l = l * al + p; o0 = o0 * al + p * bf_lo(vw); o1 = o1 * al + p * bf_hi(vw); m = mn; }
        const float il = 1.0f / l;
        *(unsigned*)(MIX + (size_t)t * DM + 1024 + hh * 128 + 2 * lane) = cvt_pk_bf16(o0 * il, o1 * il);
    }
}

namespace att {
constexpr int NW = 8, QBLK = 32, KVBLK = 64, QB = 256;
constexpr int SHM_V = KVBLK * 128 * 2;
constexpr float THR = 8.f;
#define SBAR() __builtin_amdgcn_sched_barrier(0)
__device__ __forceinline__ int v_st(int k, int c) { const int kk = (k & ~0xC) | ((k & 4) << 1) | ((k & 8) >> 1); return ((kk >> 3) * 4 + (c >> 5)) * 512 + ((kk & 7) * 32 + (c & 31)) * 2; }
__device__ __forceinline__ int v_rd_base(int lane) { return ((lane & 3) << 3) | (((lane >> 2) & 3) << 6) | (((lane >> 4) & 1) << 5) | (((lane >> 5) & 1) << 8); }
constexpr int v_rd_off(int d0, int ks, int half) { return d0 * 512 + ks * 4096 + half * 2048; }
__device__ __forceinline__ int crow(int r, int hi) { return (r & 3) + 8 * (r >> 2) + 4 * hi; }
__device__ __forceinline__ unsigned cvtpk(float lo, float hi) { unsigned r; asm volatile("v_cvt_pk_bf16_f32 %0, %1, %2" : "=v"(r) : "v"(lo), "v"(hi)); return r; }
__device__ __forceinline__ void mask_tile(f32x16& p0, f32x16& p1, int dq, unsigned W) {
    const float NEG = -__builtin_inff();
#pragma unroll
    for (int r = 0; r < 16; ++r) { const int c = (r & 3) + 8 * (r >> 2); if ((unsigned)(dq - c) >= W) p0[r] = NEG; if ((unsigned)(dq - c - 32) >= W) p1[r] = NEG; }
}
__device__ __forceinline__ void partialSM(f32x16& p0, f32x16& p1, float& m_reg, float& mn, float& alpha) {
    float pmax = p0[0];
#pragma unroll
    for (int r = 1; r < 16; ++r) pmax = fmaxf(pmax, p0[r]);
#pragma unroll
    for (int r = 0; r < 16; ++r) pmax = fmaxf(pmax, p1[r]);
    { auto rr = __builtin_amdgcn_permlane32_swap(__float_as_uint(pmax), __float_as_uint(pmax), false, false); pmax = fmaxf(__uint_as_float(rr[0]), __uint_as_float(rr[1])); }
    if (__builtin_expect(__all((pmax - m_reg) <= THR), 1)) { mn = m_reg; alpha = 1.f; }
    else { mn = fmaxf(m_reg, pmax); alpha = __builtin_amdgcn_exp2f(m_reg - mn); m_reg = mn; }
#pragma unroll
    for (int r = 0; r < 16; ++r) p0[r] = p0[r] - mn;
#pragma unroll
    for (int r = 0; r < 16; ++r) p1[r] = p1[r] - mn;
#pragma unroll
    for (int r = 0; r < 16; ++r) p0[r] = __builtin_amdgcn_exp2f(p0[r]);
}
__device__ __forceinline__ void finishSM(f32x16& p0, f32x16& p1, float alpha, float& l_reg, bf16x8& pa0, bf16x8& pa1, bf16x8& pa2, bf16x8& pa3) {
#pragma unroll
    for (int r = 0; r < 16; ++r) p1[r] = __builtin_amdgcn_exp2f(p1[r]);
    float ps = 0;
#pragma unroll
    for (int r = 0; r < 16; ++r) ps += p0[r];
#pragma unroll
    for (int r = 0; r < 16; ++r) ps += p1[r];
    { auto rr = __builtin_amdgcn_permlane32_swap(__float_as_uint(ps), __float_as_uint(ps), false, false); ps = __uint_as_float(rr[0]) + __uint_as_float(rr[1]); }
    l_reg = l_reg * alpha + ps;
#define PK4(P, B_, OUT) do { unsigned a0 = cvtpk(P[B_+0], P[B_+1]), a1 = cvtpk(P[B_+2], P[B_+3]);                          \
        unsigned b0 = cvtpk(P[B_+4], P[B_+5]), b1 = cvtpk(P[B_+6], P[B_+7]);                                             \
        auto r0 = __builtin_amdgcn_permlane32_swap(a0, b0, false, false); auto r1 = __builtin_amdgcn_permlane32_swap(a1, b1, false, false); \
        u32x4 w = {r0[0], r1[0], r0[1], r1[1]}; OUT = __builtin_bit_cast(bf16x8, w); } while (0)
    PK4(p0, 0, pa0); PK4(p0, 8, pa1); PK4(p1, 0, pa2); PK4(p1, 8, pa3);
#undef PK4
}
template <int DK, int QREG, bool SK>
__device__ __forceinline__ void qkt(f32x16& p0, f32x16& p1, LAS const char* Kslot, int r32, int hi, const bf16x8* qr, LAS const char* qlds, bool act) {
    if (SK && !act) { const float NEG = -__builtin_inff();
#pragma unroll
        for (int r = 0; r < 16; ++r) { p0[r] = NEG; p1[r] = NEG; } return; }
    p0 = f32x16{}; p1 = f32x16{};
    const int swz = (r32 & 7) << 4;
#define KADDR(d0_) (((d0_) < 8) ? (Kslot + r32 * 256 + (((((d0_) & 3) * 16 + hi * 8) * 2) ^ swz) + ((d0_) >> 2) * 128) : (Kslot + 16384 + r32 * 128 + (((((d0_) - 8) * 16 + hi * 8) * 2) ^ swz)))
#define KROW32(d0_) (((d0_) < 8) ? 32 * 256 : 32 * 128)
    bf16x8 b0 = *(LAS const bf16x8*)(KADDR(0)), b1 = *(LAS const bf16x8*)(KADDR(0) + KROW32(0));
#pragma unroll
    for (int d0 = 0; d0 < DK / 16; ++d0) {
        bf16x8 n0 = b0, n1 = b1;
        if (d0 + 1 < DK / 16) { n0 = *(LAS const bf16x8*)(KADDR(d0 + 1)); n1 = *(LAS const bf16x8*)(KADDR(d0 + 1) + KROW32(d0 + 1)); }
        bf16x8 qf; if (d0 < QREG) qf = qr[d0]; else qf = *(LAS const bf16x8*)(qlds + (d0 - QREG) * 1024);
        p0 = __builtin_amdgcn_mfma_f32_32x32x16_bf16(b0, qf, p0, 0, 0, 0);
        p1 = __builtin_amdgcn_mfma_f32_32x32x16_bf16(b1, qf, p1, 0, 0, 0);
        b0 = n0; b1 = n1; }
#undef KADDR
#undef KROW32
}
template <bool SK>
__device__ __forceinline__ void pv_tile(f32x16* o, int vb, bf16x8 pa0, bf16x8 pa1, bf16x8 pa2, bf16x8 pa3, bool act) {
    if (SK && !act) return;
#define TRRD(dst, off) asm volatile("ds_read_b64_tr_b16 %0, %1 offset:%2" : "=&v"(dst) : "v"(vb), "i"(off) : "memory")
#define WAITL(n) asm volatile("s_waitcnt lgkmcnt(" #n ")" ::: "memory")
#define PV_D0(d0) do { s16x4 l0, l1, l2, l3, h0, h1, h2, h3; constexpr int b_ = v_rd_off(d0, 0, 0); \
        TRRD(l0, b_); TRRD(h0, b_ + 2048); TRRD(l1, b_ + 4096); TRRD(h1, b_ + 6144); TRRD(l2, b_ + 8192); TRRD(h2, b_ + 10240); TRRD(l3, b_ + 12288); TRRD(h3, b_ + 14336); \
        WAITL(6); SBAR();     \
        o[d0] = __builtin_amdgcn_mfma_f32_32x32x16_bf16(pa0, (bf16x8){l0[0], l0[1], l0[2], l0[3], h0[0], h0[1], h0[2], h0[3]}, o[d0], 0, 0, 0);   \
        WAITL(4); SBAR(); \
        o[d0] = __builtin_amdgcn_mfma_f32_32x32x16_bf16(pa1, (bf16x8){l1[0], l1[1], l1[2], l1[3], h1[0], h1[1], h1[2], h1[3]}, o[d0], 0, 0, 0);   \
        WAITL(2); SBAR(); \
        o[d0] = __builtin_amdgcn_mfma_f32_32x32x16_bf16(pa2, (bf16x8){l2[0], l2[1], l2[2], l2[3], h2[0], h2[1], h2[2], h2[3]}, o[d0], 0, 0, 0);   \
        WAITL(0); SBAR(); \
        o[d0] = __builtin_amdgcn_mfma_f32_32x32x16_bf16(pa3, (bf16x8){l3[0], l3[1], l3[2], l3[3], h3[0], h3[1], h3[2], h3[3]}, o[d0], 0, 0, 0); } while (0)
    PV_D0(0); PV_D0(1); PV_D0(2); PV_D0(3);
#undef PV_D0
#undef WAITL
#undef TRRD
}
__device__ __forceinline__ void glds16(const void* gsrc, unsigned lds_dst) { unsigned keep;
    asm volatile("s_mov_b32 %0, m0\n\ts_mov_b32 m0, %2\n\ts_nop 0\n\tglobal_load_lds_dwordx4 %1, off\n\ts_mov_b32 m0, %0" : "=&s"(keep) : "v"(gsrc), "s"(lds_dst) : "memory"); }
struct Blk {
    const bf16_t* Qn; const bf16_t* Qr; int ldq, ldqr;
    const bf16_t* Kn; const bf16_t* Kr; int ldk, ldkr;
    const bf16_t* V;
    bf16_t* O; int ldo;
    float* LSE; int ldl;
    int P0, W, skv;
};
template <int DK, bool SK>
__device__ __forceinline__ void attn_block(const Blk& B, LAS char* lds) {
    constexpr int SLOT_K = (DK == 192) ? 24576 : 16384, NKP = (DK == 192) ? 3 : 2, NVP = 2;
    constexpr int QREG = (DK == 192) ? 9 : 8;
    constexpr int OFF_K = 3 * SHM_V, OFF_WS = OFF_K + 3 * SLOT_K, OFF_Q = OFF_WS + 2048;
    const int tid = threadIdx.x, wid = __builtin_amdgcn_readfirstlane(tid >> 6), lane = tid & 63, r32 = lane & 31, hi = lane >> 5;
    const int W = B.W;
    const int lowk = B.P0 - W + 1; const int j_lo = lowk > 0 ? lowk / KVBLK : 0;
    int j_hi = (B.P0 + QB - 1) / KVBLK + 1; if (j_hi > B.skv / KVBLK) j_hi = B.skv / KVBLK;
    const int NT = j_hi - j_lo;
    const int qlo = B.P0 + wid * QBLK, qm = qlo + r32 - 4 * hi;
    LAS float* wsf = (LAS float*)(lds + OFF_WS) + wid * 64; LAS float* li_l = wsf; LAS float* al_l = wsf + 32;
    LAS char* qlds = lds + OFF_Q + wid * 3072 + lane * 16;
    const unsigned lds0 = (unsigned)(uintptr_t)lds;
    float m_reg = -1e30f, l_reg = 0; f32x16 o[4] = {};
    const int krow = 4 * wid + (lane >> 4);
    const unsigned offK = (unsigned)(krow * B.ldk + (((lane & 15) ^ (krow & 7)) << 3)) * 2u;
    const int rrow = 8 * wid + (lane >> 3);
    const unsigned offR = (unsigned)(rrow * B.ldkr + (((lane & 7) ^ (rrow & 7)) << 3)) * 2u;
    const int vkk = 8 * (wid >> 1) + ((lane & 31) >> 2), vk = (vkk & ~0xC) | ((vkk & 4) << 1) | ((vkk & 8) >> 1);
    const unsigned offV = (unsigned)(vk * B.ldk + 32 * (2 * (wid & 1) + (lane >> 5)) + (lane & 3) * 8) * 2u;
    const unsigned kdst = lds0 + OFF_K + wid * 1024, vdst = lds0 + wid * 1024;
#define KBASE(t) ((j_lo + (t)) * KVBLK)
#define DMA_K(t, slot) do { const size_t kbo_ = (size_t)KBASE(t) * (size_t)B.ldk * 2; const char* kb_ = (const char*)B.Kn + kbo_; \
        glds16(kb_ + offK, (unsigned)__builtin_amdgcn_readfirstlane(kdst + (slot) * SLOT_K)); glds16(kb_ + (size_t)B.ldk * 64 + offK, (unsigned)__builtin_amdgcn_readfirstlane(kdst + (slot) * SLOT_K + 8192)); \
        if constexpr (DK == 192) glds16((const char*)B.Kr + (size_t)KBASE(t) * (size_t)B.ldkr * 2 + offR, (unsigned)__builtin_amdgcn_readfirstlane(kdst + (slot) * SLOT_K + 16384)); } while (0)
#define DMA_V(t, slot) do { const char* vb_ = (const char*)B.V + (size_t)KBASE(t) * (size_t)B.ldk * 2; \
        glds16(vb_ + offV, (unsigned)__builtin_amdgcn_readfirstlane(vdst + (slot) * SHM_V)); glds16(vb_ + (size_t)B.ldk * 64 + offV, (unsigned)__builtin_amdgcn_readfirstlane(vdst + (slot) * SHM_V + 8192)); } while (0)
#define WAIT_BAR(N) asm volatile("s_waitcnt vmcnt(%0) lgkmcnt(0)\n\ts_barrier" :: "i"(N) : "memory")
#define RESC(a) do { if (__any((a) < 1.f)) { if (hi == 0) al_l[r32] = (a); asm volatile("s_waitcnt lgkmcnt(0)" ::: "memory");              \
                     _Pragma("unroll") for (int d_ = 0; d_ < 4; ++d_) _Pragma("unroll") for (int r = 0; r < 16; ++r) o[d_][r] *= al_l[crow(r, hi)]; } } while (0)
#define ACT(t) (KBASE(t) <= qlo + QBLK - 1 && KBASE(t) + KVBLK - 1 >= qlo - W + 1)
#define MASKT(P0_, P1_, t) do { const int kb_ = KBASE(t); if ((!SK || ACT(t)) && (kb_ + KVBLK - 1 > qlo || kb_ <= qlo + QBLK - 1 - W)) mask_tile(P0_, P1_, qm - kb_, (unsigned)W); } while (0)
    bf16x8 qr[QREG];
#pragma unroll
    for (int d0 = 0; d0 < 8; ++d0) qr[d0] = *(const bf16x8*)(B.Qn + (size_t)(wid * QBLK + r32) * B.ldq + d0 * 16 + hi * 8);
    if constexpr (DK == 192) {
        qr[8] = *(const bf16x8*)(B.Qr + (size_t)(wid * QBLK + r32) * B.ldqr + hi * 8);
#pragma unroll
        for (int d0 = 9; d0 < 12; ++d0) *(LAS bf16x8*)(qlds + (d0 - QREG) * 1024) = *(const bf16x8*)(B.Qr + (size_t)(wid * QBLK + r32) * B.ldqr + (d0 - 8) * 16 + hi * 8);
    }
    DMA_K(0, 0);
    if (NT > 1) DMA_K(1, 1);
    DMA_V(0, 0);
    if (NT > 1) { WAIT_BAR(NKP + NVP); } else { WAIT_BAR(NVP); }
    int sl_prev = 0, sl_cur = 0, sl_next = 1;
#define ROT() do { sl_prev = sl_cur; sl_cur = sl_next; sl_next = (sl_next == 2) ? 0 : sl_next + 1; } while (0)
#define ENDW(t) do { if ((t) + 2 < NT) { WAIT_BAR(NKP + NVP); } else if ((t) + 1 < NT) { WAIT_BAR(NVP); } else { WAIT_BAR(0); } } while (0)
#define ISSUE(t) do { if ((t) + 2 < NT) DMA_K((t) + 2, sl_prev_k); if ((t) + 1 < NT) DMA_V((t) + 1, sl_next); } while (0)
    f32x16 pA0, pA1, pB0, pB1; float mnA, mnB, alA, alB; bf16x8 pa0, pa1, pa2, pa3;
    { const int sl_prev_k = 2;
      ISSUE(0); SBAR();
      qkt<DK, QREG, SK>(pA0, pA1, lds + OFF_K + sl_cur * SLOT_K, r32, hi, qr, qlds, ACT(0));
      MASKT(pA0, pA1, 0); partialSM(pA0, pA1, m_reg, mnA, alA);
      ENDW(0); ROT(); }
#define STEP(PX0, PX1, mnX, alX, PY0, PY1, alY, t) do { const int sl_prev_k = sl_prev;                                        \
        ISSUE(t); SBAR();                                                                                                     \
        qkt<DK, QREG, SK>(PX0, PX1, lds + OFF_K + sl_cur * SLOT_K, r32, hi, qr, qlds, ACT(t));                               \
        finishSM(PY0, PY1, alY, l_reg, pa0, pa1, pa2, pa3); SBAR();                                                           \
        pv_tile<SK>(o, (int)lds0 + v_rd_base(lane) + sl_prev * SHM_V, pa0, pa1, pa2, pa3, ACT((t) - 1));                      \
        MASKT(PX0, PX1, (t)); partialSM(PX0, PX1, m_reg, mnX, alX);                                                           \
        RESC(alX); ENDW(t); ROT(); } while (0)
    int t = 1;
    for (; t + 1 < NT; t += 2) {
        STEP(pB0, pB1, mnB, alB, pA0, pA1, alA, t);
        STEP(pA0, pA1, mnA, alA, pB0, pB1, alB, t + 1);
    }
    if (t < NT) {
        STEP(pB0, pB1, mnB, alB, pA0, pA1, alA, t);
        finishSM(pB0, pB1, alB, l_reg, pa0, pa1, pa2, pa3); SBAR();
    } else {
        finishSM(pA0, pA1, alA, l_reg, pa0, pa1, pa2, pa3); SBAR();
    }
    pv_tile<SK>(o, (int)lds0 + v_rd_base(lane) + sl_prev * SHM_V, pa0, pa1, pa2, pa3, ACT(NT - 1));
    if (hi == 0) { li_l[r32] = l_reg; if (B.LSE) B.LSE[(size_t)(wid * QBLK + r32) * B.ldl] = m_reg + __builtin_amdgcn_logf(l_reg); }
    asm volatile("s_waitcnt lgkmcnt(0)" ::: "memory");
    float rli[16];
#pragma unroll
    for (int r = 0; r < 16; ++r) rli[r] = __builtin_amdgcn_rcpf(li_l[crow(r, hi)]);
    const char* Owb = (const char*)(B.O + (size_t)(wid * QBLK) * B.ldo);
    LAS char* stg = lds + OFF_K + wid * 4608;
    const unsigned goff = (unsigned)((lane >> 3) * B.ldo * 2 + (lane & 7) * 16);
#pragma unroll
    for (int h = 0; h < 2; ++h) {
#pragma unroll
        for (int r = 0; r < 16; ++r) {
#pragma unroll
            for (int dd = 0; dd < 2; ++dd) { const float v = o[2 * h + dd][r] * rli[r];
                *(LAS unsigned short*)(stg + crow(r, hi) * 144 + (dd * 32 + r32) * 2) = (unsigned short)cvtpk(v, v); } }
        asm volatile("s_waitcnt lgkmcnt(0)" ::: "memory");
#pragma unroll
        for (int i = 0; i < 4; ++i) { const u32x4 w = *(LAS const u32x4*)(stg + (i * 8 + (lane >> 3)) * 144 + (lane & 7) * 16);
            *(u32x4*)(Owb + (size_t)(i * 8) * (size_t)B.ldo * 2 + goff + h * 128) = w; }
        asm volatile("s_waitcnt lgkmcnt(0)" ::: "memory");
    }
    asm volatile("s_waitcnt lgkmcnt(0)\n\ts_barrier" ::: "memory");
#undef KBASE
#undef DMA_K
#undef DMA_V
#undef WAIT_BAR
#undef RESC
#undef ACT
#undef MASKT
#undef ROT
#undef ENDW
#undef ISSUE
#undef STEP
}
__device__ __forceinline__ void attn_block_a(const Blk& B, LAS char* lds) {
    constexpr int SLOT_K = 16384, OFF_K = 4 * SHM_V, OFF_WS = OFF_K + 4 * SLOT_K;
    const int tid = threadIdx.x, wid = __builtin_amdgcn_readfirstlane(tid >> 6), lane = tid & 63, r32 = lane & 31, hi = lane >> 5;
    const int W = B.W;
    const int vj = (B.P0 - 128) / KVBLK;
    const int toff = (wid >= 4) ? 2 : 0;
    const int qlo = B.P0 + wid * QBLK, qm = qlo + r32 - 4 * hi;
    LAS float* wsf = (LAS float*)(lds + OFF_WS) + wid * 64; LAS float* li_l = wsf; LAS float* al_l = wsf + 32;
    const unsigned lds0 = (unsigned)(uintptr_t)lds;
    float m_reg = -1e30f, l_reg = 0; f32x16 o[4] = {};
    const int krow = 4 * wid + (lane >> 4);
    const unsigned offK = (unsigned)(krow * B.ldk + (((lane & 15) ^ (krow & 7)) << 3)) * 2u;
    const int vkk = 8 * (wid >> 1) + ((lane & 31) >> 2), vk = (vkk & ~0xC) | ((vkk & 4) << 1) | ((vkk & 8) >> 1);
    const unsigned offV = (unsigned)(vk * B.ldk + 32 * (2 * (wid & 1) + (lane >> 5)) + (lane & 3) * 8) * 2u;
    const unsigned kdst = lds0 + OFF_K + wid * 1024, vdst = lds0 + wid * 1024;
#define TREAL(x) ((vj + (x)) < 0 ? 0 : (vj + (x)))
#define DMA_K(x) do { const char* kb_ = (const char*)B.Kn + (size_t)(TREAL(x) * KVBLK) * (size_t)B.ldk * 2; \
        glds16(kb_ + offK, (unsigned)__builtin_amdgcn_readfirstlane(kdst + ((x) & 3) * SLOT_K)); glds16(kb_ + (size_t)B.ldk * 64 + offK, (unsigned)__builtin_amdgcn_readfirstlane(kdst + ((x) & 3) * SLOT_K + 8192)); } while (0)
#define DMA_V(x) do { const char* vb_ = (const char*)B.V + (size_t)(TREAL(x) * KVBLK) * (size_t)B.ldk * 2; \
        glds16(vb_ + offV, (unsigned)__builtin_amdgcn_readfirstlane(vdst + ((x) & 3) * SHM_V)); glds16(vb_ + (size_t)B.ldk * 64 + offV, (unsigned)__builtin_amdgcn_readfirstlane(vdst + ((x) & 3) * SHM_V + 8192)); } while (0)
#define WAIT_BAR(N) asm volatile("s_waitcnt vmcnt(%0) lgkmcnt(0)\n\ts_barrier" :: "i"(N) : "memory")
#define RESC(a) do { if (__any((a) < 1.f)) { if (hi == 0) al_l[r32] = (a); asm volatile("s_waitcnt lgkmcnt(0)" ::: "memory");              \
                     _Pragma("unroll") for (int d_ = 0; d_ < 4; ++d_) _Pragma("unroll") for (int r = 0; r < 16; ++r) o[d_][r] *= al_l[crow(r, hi)]; } } while (0)
#define TW(s) ((s) + toff)
#define KB_(s) ((vj + TW(s)) * KVBLK)
#define ACT(s) ((vj + TW(s)) >= 0 && KB_(s) <= qlo + QBLK - 1 && KB_(s) + KVBLK - 1 >= qlo - W + 1)
#define MASKT(P0_, P1_, s) do { const int kb_ = KB_(s); if (ACT(s) && (kb_ + KVBLK - 1 > qlo || kb_ <= qlo + QBLK - 1 - W)) mask_tile(P0_, P1_, qm - kb_, (unsigned)W); } while (0)
#define KSLOT(s) (lds + OFF_K + (TW(s) & 3) * SLOT_K)
#define VSLOT(s) ((int)lds0 + v_rd_base(lane) + (TW(s) & 3) * SHM_V)
    bf16x8 qr[8];
#pragma unroll
    for (int d0 = 0; d0 < 8; ++d0) qr[d0] = *(const bf16x8*)(B.Qn + (size_t)(wid * QBLK + r32) * B.ldq + d0 * 16 + hi * 8);
    DMA_K(0); DMA_K(1); DMA_K(2); DMA_K(3); DMA_V(0); DMA_V(2);
    WAIT_BAR(4);
    f32x16 pA0, pA1, pB0, pB1; float mnA, mnB, alA, alB; bf16x8 pa0, pa1, pa2, pa3;
    DMA_V(1); DMA_V(3); SBAR();
    qkt<128, 8, true>(pA0, pA1, KSLOT(0), r32, hi, qr, nullptr, ACT(0));
    MASKT(pA0, pA1, 0); partialSM(pA0, pA1, m_reg, mnA, alA);
    WAIT_BAR(4);
    DMA_K(4); SBAR();
    qkt<128, 8, true>(pB0, pB1, KSLOT(1), r32, hi, qr, nullptr, ACT(1));
    finishSM(pA0, pA1, alA, l_reg, pa0, pa1, pa2, pa3); SBAR();
    pv_tile<true>(o, VSLOT(0), pa0, pa1, pa2, pa3, ACT(0));
    MASKT(pB0, pB1, 1); partialSM(pB0, pB1, m_reg, mnB, alB); RESC(alB);
    WAIT_BAR(0);
    DMA_K(5); DMA_V(4); SBAR();
    qkt<128, 8, true>(pA0, pA1, KSLOT(2), r32, hi, qr, nullptr, ACT(2));
    finishSM(pB0, pB1, alB, l_reg, pa0, pa1, pa2, pa3); SBAR();
    pv_tile<true>(o, VSLOT(1), pa0, pa1, pa2, pa3, ACT(1));
    MASKT(pA0, pA1, 2); partialSM(pA0, pA1, m_reg, mnA, alA); RESC(alA);
    WAIT_BAR(0);
    DMA_V(5); SBAR();
    qkt<128, 8, true>(pB0, pB1, KSLOT(3), r32, hi, qr, nullptr, ACT(3));
    finishSM(pA0, pA1, alA, l_reg, pa0, pa1, pa2, pa3); SBAR();
    pv_tile<true>(o, VSLOT(2), pa0, pa1, pa2, pa3, ACT(2));
    MASKT(pB0, pB1, 3); partialSM(pB0, pB1, m_reg, mnB, alB); RESC(alB);
    WAIT_BAR(0);
    finishSM(pB0, pB1, alB, l_reg, pa0, pa1, pa2, pa3); SBAR();
    pv_tile<true>(o, VSLOT(3), pa0, pa1, pa2, pa3, ACT(3));
    if (hi == 0) { li_l[r32] = l_reg; if (B.LSE) B.LSE[(size_t)(wid * QBLK + r32) * B.ldl] = m_reg + __builtin_amdgcn_logf(l_reg); }
    asm volatile("s_waitcnt lgkmcnt(0)" ::: "memory");
    float rli[16];
#pragma unroll
    for (int r = 0; r < 16; ++r) rli[r] = __builtin_amdgcn_rcpf(li_l[crow(r, hi)]);
    const char* Owb = (const char*)(B.O + (size_t)(wid * QBLK) * B.ldo);
    LAS char* stg = lds + OFF_K + wid * 4608;
    const unsigned goff = (unsigned)((lane >> 3) * B.ldo * 2 + (lane & 7) * 16);
#pragma unroll
    for (int h = 0; h < 2; ++h) {
#pragma unroll
        for (int r = 0; r < 16; ++r) {
#pragma unroll
            for (int dd = 0; dd < 2; ++dd) { const float v = o[2 * h + dd][r] * rli[r];
                *(LAS unsigned short*)(stg + crow(r, hi) * 144 + (dd * 32 + r32) * 2) = (unsigned short)cvtpk(v, v); } }
        asm volatile("s_waitcnt lgkmcnt(0)" ::: "memory");
#pragma unroll
        for (int i = 0; i < 4; ++i) { const u32x4 w = *(LAS const u32x4*)(stg + (i * 8 + (lane >> 3)) * 144 + (lane & 7) * 16);
            *(u32x4*)(Owb + (size_t)(i * 8) * (size_t)B.ldo * 2 + goff + h * 128) = w; }
        asm volatile("s_waitcnt lgkmcnt(0)" ::: "memory");
    }
    asm volatile("s_waitcnt lgkmcnt(0)\n\ts_barrier" ::: "memory");
#undef TREAL
#undef DMA_K
#undef DMA_V
#undef WAIT_BAR
#undef RESC
#undef TW
#undef KB_
#undef ACT
#undef MASKT
#undef KSLOT
#undef VSLOT
}
#undef SBAR
}

#if ATTN_A_SEAM
namespace att {
#define SBAR() __builtin_amdgcn_sched_barrier(0)
__device__ __forceinline__ Blk a_decode(const Args& a, int it) {
    const bf16_t* PROJ = (const bf16_t*)(a.ws + WS_PROJ); float* LSE = (float*)(a.ws + WS_LSE);
    const int bh = it / 48, x = it % 48, b = bh >> 3, hh = bh & 7;
    int c, d, r, qb, slen;
    if (x < 16) { c = 0; d = 1; r = 0; qb = x; slen = 4096; } else if (x < 32) { c = 1; d = 4; r = (x - 16) >> 2; qb = (x - 16) & 3; slen = 1024; } else { c = 2; d = 16; r = x - 32; qb = 0; slen = 256; }
    const long row0 = (long)b * SEQ + r;
    Blk B;
    B.ldq = d * NPROJ; B.ldk = B.ldq; B.ldqr = 0; B.ldkr = 0; B.Qr = nullptr; B.Kr = nullptr;
    B.P0 = qb * 256; B.W = 129; B.skv = slen;
    B.Qn = PROJ + (row0 + (long)B.P0 * d) * NPROJ + hh * 128;
    B.Kn = PROJ + row0 * NPROJ + 1024 + hh * 128; B.V = PROJ + row0 * NPROJ + 2048 + hh * 128;
    if (c == 0) { B.O = (bf16_t*)(a.ws + WS_HB) + (row0 + (long)B.P0 * d) * DM + hh * 128; B.ldo = d * DM; }
    else { B.O = (bf16_t*)(a.ws + WS_Y + (size_t)(c - 1) * 32 * MiB) + (row0 + (long)B.P0 * d) * 1024 + hh * 128; B.ldo = d * 1024; }
    B.LSE = LSE + (size_t)c * T * 8 + (row0 + (long)B.P0 * d) * 8 + hh; B.ldl = d * 8;
    return B;
}
__device__ __forceinline__ void attn_a_stream(const Args& a, LAS char* lds) {
    constexpr int SLOT_K = 16384, OFF_K = 4 * SHM_V, OFF_WS = OFF_K + 4 * SLOT_K;
    const int tid = threadIdx.x, wid = __builtin_amdgcn_readfirstlane(tid >> 6), lane = tid & 63, r32 = lane & 31, hi = lane >> 5;
    unsigned* qctr = (unsigned*)(a.ws + WS_QCTR);
    volatile LAS unsigned* qslot = (volatile LAS unsigned*)(lds + MISC_OFF);
    const int xq0 = blockIdx.x & 7; int qoff = 0;
    unsigned pre_v = 0u;
#define RESOLVE(v_, code_) do { unsigned vv_ = (v_); code_ = 0xffffffffu; for (;;) { const int xq_ = (xq0 + qoff) & 7; \
        if (vv_ < 192u) { code_ = (unsigned)((xq_ + 8 * (int)(vv_ / 48u)) * 48 + (int)(vv_ % 48u)); break; } \
        if (++qoff >= 8) break; vv_ = __hip_atomic_fetch_add(qctr + 64 * ((xq0 + qoff) & 7), 1u, __ATOMIC_RELAXED, __HIP_MEMORY_SCOPE_AGENT); } } while (0)
#define TICKET() __hip_atomic_fetch_add(qctr + 64 * ((xq0 + qoff) & 7), 1u, __ATOMIC_RELAXED, __HIP_MEMORY_SCOPE_AGENT)
    if (tid == 0) { unsigned c0; const unsigned v0 = TICKET(); RESOLVE(v0, c0); qslot[0] = c0; if (c0 != 0xffffffffu) pre_v = TICKET(); }
    __syncthreads();
    unsigned code = qslot[0];
    __syncthreads();
    if (code == 0xffffffffu) return;
    Blk B = a_decode(a, (int)code);
    const int toff = (wid >= 4) ? 2 : 0;
    LAS float* wsf = (LAS float*)(lds + OFF_WS) + wid * 64; LAS float* li_l = wsf; LAS float* al_l = wsf + 32;
    const unsigned lds0 = (unsigned)(uintptr_t)lds;
    const int krow = 4 * wid + (lane >> 4);
    const int vkk = 8 * (wid >> 1) + ((lane & 31) >> 2), vk = (vkk & ~0xC) | ((vkk & 4) << 1) | ((vkk & 8) >> 1);
    const unsigned kdst = lds0 + OFF_K + wid * 1024, vdst = lds0 + wid * 1024;
#define OFFK(Bx) ((unsigned)(krow * (Bx).ldk + (((lane & 15) ^ (krow & 7)) << 3)) * 2u)
#define OFFV(Bx) ((unsigned)(vk * (Bx).ldk + 32 * (2 * (wid & 1) + (lane >> 5)) + (lane & 3) * 8) * 2u)
#define VJ(Bx) (((Bx).P0 - 128) / KVBLK)
#define TREAL(Bx, x) ((VJ(Bx) + (x)) < 0 ? 0 : (VJ(Bx) + (x)))
#define DMA_K(Bx, x) do { const char* kb_ = (const char*)(Bx).Kn + (size_t)(TREAL(Bx, x) * KVBLK) * (size_t)(Bx).ldk * 2; const unsigned ok_ = OFFK(Bx); \
        glds16(kb_ + ok_, (unsigned)__builtin_amdgcn_readfirstlane(kdst + SL(x) * SLOT_K)); glds16(kb_ + (size_t)(Bx).ldk * 64 + ok_, (unsigned)__builtin_amdgcn_readfirstlane(kdst + SL(x) * SLOT_K + 8192)); } while (0)
#define DMA_V(Bx, x) do { const char* vb_ = (const char*)(Bx).V + (size_t)(TREAL(Bx, x) * KVBLK) * (size_t)(Bx).ldk * 2; const unsigned ov_ = OFFV(Bx); \
        glds16(vb_ + ov_, (unsigned)__builtin_amdgcn_readfirstlane(vdst + SL(x) * SHM_V)); glds16(vb_ + (size_t)(Bx).ldk * 64 + ov_, (unsigned)__builtin_amdgcn_readfirstlane(vdst + SL(x) * SHM_V + 8192)); } while (0)
#define QLOAD(Bx) do { _Pragma("unroll") for (int d0 = 0; d0 < 8; ++d0) qr[d0] = *(const bf16x8*)((Bx).Qn + (size_t)(wid * QBLK + r32) * (Bx).ldq + d0 * 16 + hi * 8); } while (0)
#define WAIT_BAR(N) asm volatile("s_waitcnt vmcnt(%0) lgkmcnt(0)\n\ts_barrier" :: "i"(N) : "memory")
#define RESC(a_) do { if (__any((a_) < 1.f)) { if (hi == 0) al_l[r32] = (a_); asm volatile("s_waitcnt lgkmcnt(0)" ::: "memory");              \
                     _Pragma("unroll") for (int d_ = 0; d_ < 4; ++d_) _Pragma("unroll") for (int r = 0; r < 16; ++r) o[d_][r] *= al_l[crow(r, hi)]; } } while (0)
#define TW0_0 0
#define TW0_1 2
#define TW0_2 3
#define TW0_3 1
#define TW1_0 5
#define TW1_1 3
#define TW1_2 2
#define TW1_3 4
#define TW(s) (toff ? TW1_##s : TW0_##s)
#define SL(x) (((x) == 0 || (x) == 1) ? 0 : (((x) == 5 || (x) == 4) ? 1 : ((x) == 2 ? 2 : 3)))
#define KB_(s) ((vj + TW(s)) * KVBLK)
#define ACT(s) ((vj + TW(s)) >= 0 && KB_(s) <= qlo + QBLK - 1 && KB_(s) + KVBLK - 1 >= qlo - W + 1)
#define MASKT(P0_, P1_, s) do { const int kb_ = KB_(s); if (ACT(s) && (kb_ + KVBLK - 1 > qlo || kb_ <= qlo + QBLK - 1 - W)) mask_tile(P0_, P1_, qm - kb_, (unsigned)W); } while (0)
#define KSLOT(s) (lds + OFF_K + SL(TW(s)) * SLOT_K)
#define VSLOT(s) ((int)lds0 + v_rd_base(lane) + SL(TW(s)) * SHM_V)
    bf16x8 qr[8];
    QLOAD(B); DMA_K(B, 0); DMA_K(B, 5); DMA_K(B, 2); DMA_K(B, 3); DMA_V(B, 0); DMA_V(B, 5);
    for (;;) {
        const int W = B.W, vj = VJ(B);
        const int qlo = B.P0 + wid * QBLK, qm = qlo + r32 - 4 * hi;
        float m_reg = -1e30f, l_reg = 0; f32x16 o[4] = {};
        unsigned long long tq0_ = 0; if (PROBE_T == 40 || PROBE_T == 42) tq0_ = __builtin_amdgcn_s_memrealtime();
        WAIT_BAR(4);
        if (PROBE_T == 42) { const unsigned long long t1_ = __builtin_amdgcn_s_memrealtime(), dt_ = t1_ - tq0_; while (__builtin_amdgcn_s_memrealtime() - t1_ < dt_) __builtin_amdgcn_s_sleep(2); }
        f32x16 pA0, pA1, pB0, pB1; float mnA, mnB, alA, alB; bf16x8 pa0, pa1, pa2, pa3;
        DMA_V(B, 2); DMA_V(B, 3); SBAR();
        qkt<128, 8, true>(pA0, pA1, KSLOT(0), r32, hi, qr, nullptr, ACT(0));
        MASKT(pA0, pA1, 0); partialSM(pA0, pA1, m_reg, mnA, alA);
        WAIT_BAR(4);
        DMA_K(B, 1); DMA_K(B, 4); SBAR();
        qkt<128, 8, true>(pB0, pB1, KSLOT(1), r32, hi, qr, nullptr, ACT(1));
        finishSM(pA0, pA1, alA, l_reg, pa0, pa1, pa2, pa3); SBAR();
        pv_tile<true>(o, VSLOT(0), pa0, pa1, pa2, pa3, ACT(0));
        MASKT(pB0, pB1, 1); partialSM(pB0, pB1, m_reg, mnB, alB); RESC(alB);
        if (tid == 0) { unsigned cn; RESOLVE(pre_v, cn); qslot[0] = cn; if (cn != 0xffffffffu) pre_v = TICKET(); }
        WAIT_BAR(4);
        const unsigned ncode = qslot[0]; const bool more = ncode != 0xffffffffu;
        Blk Bn = B; if (more) Bn = a_decode(a, (int)ncode);
        DMA_V(B, 1); DMA_V(B, 4); SBAR();
        qkt<128, 8, true>(pA0, pA1, KSLOT(2), r32, hi, qr, nullptr, ACT(2));
        finishSM(pB0, pB1, alB, l_reg, pa0, pa1, pa2, pa3); SBAR();
        pv_tile<true>(o, VSLOT(1), pa0, pa1, pa2, pa3, ACT(1));
        MASKT(pA0, pA1, 2); partialSM(pA0, pA1, m_reg, mnA, alA); RESC(alA);
        WAIT_BAR(4);
        SBAR();
        qkt<128, 8, true>(pB0, pB1, KSLOT(3), r32, hi, qr, nullptr, ACT(3));
        finishSM(pA0, pA1, alA, l_reg, pa0, pa1, pa2, pa3); SBAR();
        pv_tile<true>(o, VSLOT(2), pa0, pa1, pa2, pa3, ACT(2));
        MASKT(pB0, pB1, 3); partialSM(pB0, pB1, m_reg, mnB, alB); RESC(alB);
        WAIT_BAR(0);
        if (PROBE_T == 40) { const unsigned long long t1_ = __builtin_amdgcn_s_memrealtime(), dt_ = t1_ - tq0_; while (__builtin_amdgcn_s_memrealtime() - t1_ < dt_) __builtin_amdgcn_s_sleep(2); }
        unsigned long long tq1_ = 0; if (PROBE_T == 41 || PROBE_T == 43) tq1_ = __builtin_amdgcn_s_memrealtime();
        if (more) { QLOAD(Bn); DMA_K(Bn, 0); DMA_K(Bn, 5); DMA_K(Bn, 2); DMA_K(Bn, 3); }
        SBAR();
        finishSM(pB0, pB1, alB, l_reg, pa0, pa1, pa2, pa3); SBAR();
        pv_tile<true>(o, VSLOT(3), pa0, pa1, pa2, pa3, ACT(3));
        if (PROBE_T == 43) { __builtin_amdgcn_s_barrier(); const unsigned long long t1_ = __builtin_amdgcn_s_memrealtime(), dt_ = t1_ - tq1_; while (__builtin_amdgcn_s_memrealtime() - t1_ < dt_) __builtin_amdgcn_s_sleep(2); }
        unsigned long long tq2_ = 0; if (PROBE_T == 44 || PROBE_T == 45) tq2_ = __builtin_amdgcn_s_memrealtime();
        if (hi == 0) { li_l[r32] = l_reg; B.LSE[(size_t)(wid * QBLK + r32) * B.ldl] = m_reg + __builtin_amdgcn_logf(l_reg); }
        asm volatile("s_waitcnt lgkmcnt(0)" ::: "memory");
        float rli[16];
#pragma unroll
        for (int r = 0; r < 16; ++r) rli[r] = __builtin_amdgcn_rcpf(li_l[crow(r, hi)]);
        if (PROBE_T == 44) { const unsigned long long t1_ = __builtin_amdgcn_s_memrealtime(), dt_ = t1_ - tq2_; while (__builtin_amdgcn_s_memrealtime() - t1_ < dt_) __builtin_amdgcn_s_sleep(2); }
        const char* Owb = (const char*)(B.O + (size_t)(wid * QBLK) * B.ldo);
        LAS char* stg = lds + (2 + (wid >> 2)) * SHM_V + (wid & 3) * 4096;
        const unsigned goff = (unsigned)((lane >> 3) * B.ldo * 2 + (lane & 7) * 16);
#pragma unroll
        for (int h = 0; h < 2; ++h) {
#pragma unroll
            for (int r = 0; r < 16; ++r) {
#pragma unroll
                for (int dd = 0; dd < 2; ++dd) { const float v = o[2 * h + dd][r] * rli[r];
                    *(LAS unsigned short*)(stg + crow(r, hi) * 128 + (dd * 32 + r32) * 2) = (unsigned short)cvtpk(v, v); } }
            asm volatile("s_waitcnt lgkmcnt(0)" ::: "memory");
#pragma unroll
            for (int i = 0; i < 4; ++i) { const u32x4 w = *(LAS const u32x4*)(stg + (i * 8 + (lane >> 3)) * 128 + (lane & 7) * 16);
                *(u32x4*)(Owb + (size_t)(i * 8) * (size_t)B.ldo * 2 + goff + h * 128) = w; }
            asm volatile("s_waitcnt lgkmcnt(0)" ::: "memory");
        }
        if (PROBE_T == 45) { const unsigned long long t1_ = __builtin_amdgcn_s_memrealtime(), dt_ = t1_ - tq2_; while (__builtin_amdgcn_s_memrealtime() - t1_ < dt_) __builtin_amdgcn_s_sleep(2); }
        asm volatile("s_waitcnt lgkmcnt(0)\n\ts_barrier" ::: "memory");
        if (PROBE_T == 41) { const unsigned long long t1_ = __builtin_amdgcn_s_memrealtime(), dt_ = t1_ - tq1_; while (__builtin_amdgcn_s_memrealtime() - t1_ < dt_) __builtin_amdgcn_s_sleep(2); }
        if (!more) break;
        DMA_V(Bn, 0); DMA_V(Bn, 5);
        B = Bn;
    }
#undef RESOLVE
#undef TICKET
#undef OFFK
#undef OFFV
#undef VJ
#undef TREAL
#undef DMA_K
#undef DMA_V
#undef QLOAD
#undef WAIT_BAR
#undef RESC
#undef TW
#undef SL
#undef KB_
#undef ACT
#undef MASKT
#undef KSLOT
#undef VSLOT
}
#undef SBAR
}
#endif

__device__ __forceinline__ void fast_attn_a(const Args& a, LAS char* lds) {
#if ATTN_A_SEAM
    att::attn_a_stream(a, lds); return;
#endif
    const bf16_t* PROJ = (const bf16_t*)(a.ws + WS_PROJ);
    float* LSE = (float*)(a.ws + WS_LSE);
    unsigned* qctr = (unsigned*)(a.ws + WS_QCTR);
    volatile LAS unsigned* qslot = (volatile LAS unsigned*)(lds + MISC_OFF);
    const int xq0 = blockIdx.x & 7; int qoff = 0;
    unsigned pre_v = 0u; bool have_pre = false;
    for (;;) {
        if (threadIdx.x == 0) { unsigned code = 0xffffffffu; int q = qoff; bool use_pre = have_pre;
            for (; q < 8; ++q) { const int xq = (xq0 + q) & 7; unsigned v;
                if (use_pre) v = pre_v; else v = __hip_atomic_fetch_add(qctr + 64 * xq, 1u, __ATOMIC_RELAXED, __HIP_MEMORY_SCOPE_AGENT);
                use_pre = false;
                if (v < 192u) { code = (unsigned)((xq + 8 * (int)(v / 48u)) * 48 + (int)(v % 48u)); break; } }
            qslot[0] = code; qslot[1] = (unsigned)q; }
        __syncthreads();
        const unsigned code = qslot[0]; qoff = (int)qslot[1];
        __syncthreads();
        if (code == 0xffffffffu) break;
        if (threadIdx.x == 0) { pre_v = __hip_atomic_fetch_add(qctr + 64 * ((xq0 + qoff) & 7), 1u, __ATOMIC_RELAXED, __HIP_MEMORY_SCOPE_AGENT); have_pre = true; }
        const int it = (int)code;
        const int bh = it / 48, x = it % 48, b = bh >> 3, hh = bh & 7;
        int c, d, r, qb, slen;
        if (x < 16) { c = 0; d = 1; r = 0; qb = x; slen = 4096; } else if (x < 32) { c = 1; d = 4; r = (x - 16) >> 2; qb = (x - 16) & 3; slen = 1024; } else { c = 2; d = 16; r = x - 32; qb = 0; slen = 256; }
        const long row0 = (long)b * SEQ + r;
        att::Blk B;
        B.ldq = d * NPROJ; B.ldk = B.ldq; B.ldqr = 0; B.ldkr = 0; B.Qr = nullptr; B.Kr = nullptr;
        B.P0 = qb * 256; B.W = 129; B.skv = slen;
        B.Qn = PROJ + (row0 + (long)B.P0 * d) * NPROJ + hh * 128;
        B.Kn = PROJ + row0 * NPROJ + 1024 + hh * 128; B.V = PROJ + row0 * NPROJ + 2048 + hh * 128;
        if (c == 0) { B.O = (bf16_t*)(a.ws + WS_HB) + (row0 + (long)B.P0 * d) * DM + hh * 128; B.ldo = d * DM; }
        else { B.O = (bf16_t*)(a.ws + WS_Y + (size_t)(c - 1) * 32 * MiB) + (row0 + (long)B.P0 * d) * 1024 + hh * 128; B.ldo = d * 1024; }
        B.LSE = LSE + (size_t)c * T * 8 + (row0 + (long)B.P0 * d) * 8 + hh; B.ldl = d * 8;
#if ATTN_A_SKEW
        att::attn_block_a(B, lds);
#else
        att::attn_block<128, true>(B, lds);
#endif
    }
}
__device__ __forceinline__ void merge_a(const Args& a) {
    const float* LSE = (const float*)(a.ws + WS_LSE); bf16_t* MIX = (bf16_t*)(a.ws + WS_HB);
    const bf16_t* O1 = (const bf16_t*)(a.ws + WS_Y); const bf16_t* O2 = (const bf16_t*)(a.ws + WS_Y + 32 * MiB);
    const long total = (long)T * 128;
    for (long idx = (long)blockIdx.x * NTHREADS + threadIdx.x; idx < total; idx += (long)gridDim.x * NTHREADS) {
        const long t = idx >> 7; const int cg8 = (int)(idx & 127), hh = cg8 >> 4;
        const float l0 = LSE[t * 8 + hh], l1 = LSE[(size_t)T * 8 + t * 8 + hh], l2 = LSE[(size_t)2 * T * 8 + t * 8 + hh];
        const float mx = fmaxf(l0, fmaxf(l1, l2)); float w0 = exp2f(l0 - mx), w1 = exp2f(l1 - mx), w2 = exp2f(l2 - mx); const float inv = 1.0f / (w0 + w1 + w2); w0 *= inv; w1 *= inv; w2 *= inv;
        float v0[8], v1[8], v2[8]; load8f(MIX + t * DM + cg8 * 8, v0); load8f(O1 + t * 1024 + cg8 * 8, v1); load8f(O2 + t * 1024 + cg8 * 8, v2);
#pragma unroll
        for (int j = 0; j < 8; ++j) v0[j] = w0 * v0[j] + w1 * v1[j] + w2 * v2[j];
        store8(MIX + t * DM + cg8 * 8, v0);
    }
}
__device__ __forceinline__ void fast_attn_b(const Args& a, LAS char* lds) {
    const bf16_t* PROJ = (const bf16_t*)(a.ws + WS_PROJ); const bf16_t* QB = (const bf16_t*)(a.ws + WS_QB); const bf16_t* KVB = (const bf16_t*)(a.ws + WS_KVB); bf16_t* MIX = (bf16_t*)(a.ws + WS_HB);
    for (int it0 = blockIdx.x; it0 < 256; it0 += gridDim.x) {
        const int it = (gridDim.x == 256) ? ((it0 & 7) * 32 + (it0 >> 3)) : it0;
        const int bh = it >> 3, s8 = it & 7, b = bh >> 3, hh = bh & 7;
        for (int pass = 0; pass < 2; ++pass) {
            const int qb = pass ? 15 - s8 : s8; const long row0 = (long)b * SEQ;
            att::Blk B;
            B.P0 = qb * 256; B.W = 1 << 30; B.skv = SEQ;
            B.Qn = QB + (row0 + B.P0) * 1536 + hh * 128; B.ldq = 1536; B.Qr = QB + (row0 + B.P0) * 1536 + 1024 + hh * 64; B.ldqr = 1536;
            B.Kn = KVB + row0 * 2048 + hh * 256; B.ldk = 2048; B.Kr = PROJ + row0 * NPROJ + 4096; B.ldkr = NPROJ;
            B.V = KVB + row0 * 2048 + hh * 256 + 128;
            B.O = MIX + (row0 + B.P0) * DM + 1024 + hh * 128; B.ldo = DM; B.LSE = nullptr; B.ldl = 0;
            att::attn_block<192, false>(B, lds);
        }
    }
}


__device__ __forceinline__ void kr_phase(const Args& a, const Ctx& C, LAS unsigned char* lds) {
    constexpr int RSB = 2064;
    const int tid = threadIdx.x, wid = tid >> 6, lane = tid & 63, r16 = lane & 15, quad = lane >> 4;
    const bf16_t* HB = (const bf16_t*)(a.ws + WS_HB); const bf16_t* BT = (const bf16_t*)(a.ws + WS_BTIN) + (size_t)4096 * DM;
    for (int it = blockIdx.x; it < T / 64; it += gridDim.x) {
        const int tok = it * 64 + (wid >> 1) * 16 + r16;
        f32x4 acc[4];
#pragma unroll
        for (int nt = 0; nt < 4; ++nt) acc[nt] = (f32x4){0.f, 0.f, 0.f, 0.f};
#pragma unroll 1
        for (int kh = 0; kh < 2; ++kh) {
            __syncthreads();
#pragma unroll
            for (int i = 0; i < 16; ++i) { const int id = tid + 512 * i, row = id >> 7, c = id & 127;
                *(LAS u32x4*)(lds + row * RSB + c * 16) = *(const u32x4*)(BT + (size_t)row * DM + kh * 1024 + c * 8); }
            __syncthreads();
            const bf16_t* hp = HB + (size_t)tok * DM + kh * 1024 + (wid & 1) * 512 + quad * 8;
            const LAS unsigned char* bp = lds + r16 * RSB + ((wid & 1) * 512 + quad * 8) * 2;
#pragma unroll 8
            for (int k0 = 0; k0 < 512; k0 += 32) {
                const bf16x8 hv = *(const bf16x8*)(hp + k0);
#pragma unroll
                for (int nt = 0; nt < 4; ++nt) { const bf16x8 wv = *(const LAS bf16x8*)(bp + nt * 16 * RSB + k0 * 2); acc[nt] = __builtin_amdgcn_mfma_f32_16x16x32_bf16(wv, hv, acc[nt], 0, 0, 0); }
            }
        }
        __syncthreads();
        LAS f32x4* xch = (LAS f32x4*)lds + (wid >> 1) * 256 + lane;
        if (wid & 1) {
#pragma unroll
            for (int nt = 0; nt < 4; ++nt) xch[nt * 64] = acc[nt]; }
        __syncthreads();
        if ((wid & 1) == 0) {
#pragma unroll
            for (int nt = 0; nt < 4; ++nt) { const f32x4 v = acc[nt] + xch[nt * 64];
                f32x4 pv; pv.x = __shfl_xor(v.x, 16); pv.y = __shfl_xor(v.y, 16); pv.z = __shfl_xor(v.z, 16); pv.w = __shfl_xor(v.w, 16);
                const int i0 = 16 * (nt >> 1) + 8 * (nt & 1) + 4 * (quad >> 1);
                const f32x4 cs = *(const f32x4*)(C.COSB + (size_t)tok * 32 + i0), sn = *(const f32x4*)(C.SINB + (size_t)tok * 32 + i0);
                f32x4 o; if ((quad & 1) == 0) o = v * cs - pv * sn; else o = v * cs + pv * sn;
                u32x2 w; w.x = cvt_pk_bf16(o.x, o.y); w.y = cvt_pk_bf16(o.z, o.w);
                *(u32x2*)(C.PROJ + (size_t)tok * NPROJ + 4096 + nt * 16 + quad * 4) = w; }
        }
    }
    __syncthreads();
}

#define RLX_AGENT __ATOMIC_RELAXED, __HIP_MEMORY_SCOPE_AGENT
#define XB_TMO      128
#define XB_XCNT(j)  (256  + 64 * (j))
#define XB_XSUB(j)  (1280 + 64 * (j))
#define XB_XGEN(j)  (2304 + 64 * (j))
#define XB_TOP      3328
#define XB_TOPGEN   3392
#define XCD_BAR_WORDS 3456
#define XB_SPIN_CAP (1u << 18)

__device__ __forceinline__ unsigned xb_ld(unsigned* p)              { return __hip_atomic_load(p, __ATOMIC_RELAXED, __HIP_MEMORY_SCOPE_AGENT); }
__device__ __forceinline__ unsigned xb_add(unsigned* p, unsigned v) { return __hip_atomic_fetch_add(p, v, __ATOMIC_RELAXED, __HIP_MEMORY_SCOPE_AGENT); }
__device__ __forceinline__ unsigned xb_xcc_id() { return (unsigned)__builtin_amdgcn_s_getreg((3 << 11) | 20) & 0xFu; }
#define XB_SPIN(cond, bar) do { unsigned _sp = 0; while (cond) { __builtin_amdgcn_s_sleep(1); \
    if ((++_sp & 255u) == 0u) { if (xb_ld(&(bar)[XB_TMO])) break; if (_sp > XB_SPIN_CAP) { atomicAdd(&(bar)[XB_TMO], 1u); break; } } } } while (0)

struct XcdBarrier {
    unsigned* bar; unsigned x;
    volatile LAS unsigned* st;
};

__device__ __forceinline__ XcdBarrier xcd_barrier_post(unsigned* bar, volatile LAS unsigned* st) {
    XcdBarrier b; b.bar = bar; b.x = xb_xcc_id(); b.st = st;
    if (threadIdx.x == 0) (void)xb_add(&bar[XB_XCNT(b.x)], 1u);
    return b;
}
__device__ __forceinline__ void xcd_barrier_complete(unsigned* bar, unsigned x, unsigned& nloc, unsigned& nx) {
    const unsigned G = gridDim.x * gridDim.y * gridDim.z;
    unsigned sum, cnt, mine, sp = 0u;
    for (;;) {
        sum = 0u; cnt = 0u; mine = 0u;
#pragma unroll
        for (unsigned j = 0; j < 16; ++j) { const unsigned c = xb_ld(&bar[XB_XCNT(j)]); sum += c; cnt += (c > 0u) ? 1u : 0u; mine = (j == x) ? c : mine; }
        if (sum == G) break;
        __builtin_amdgcn_s_sleep(1);
        if ((++sp & 255u) == 0u) { if (xb_ld(&bar[XB_TMO])) break; if (sp > XB_SPIN_CAP) { atomicAdd(&bar[XB_TMO], 1u); break; } }
    }
    nloc = mine > 0u ? mine : 1u; nx = cnt > 0u ? cnt : 1u;
}

__device__ __forceinline__ void xcd_barrier(const XcdBarrier& b) {
    asm volatile("s_waitcnt vmcnt(0)" ::: "memory");
    __syncthreads();
    if (threadIdx.x == 0) {
        unsigned* bar = b.bar;
        __builtin_amdgcn_s_waitcnt(0);
        unsigned nloc = b.st[0], nx = b.st[1];
        if (nloc == 0u) { xcd_barrier_complete(bar, b.x, nloc, nx); b.st[0] = nloc; b.st[1] = nx; }
        const unsigned old = xb_add(&bar[XB_XSUB(b.x)], 1u);
        const unsigned gen = old / nloc;
        if (old + 1u == (gen + 1u) * nloc) {
            __builtin_amdgcn_fence(__ATOMIC_RELEASE, "agent");
            asm volatile("s_waitcnt vmcnt(0)" ::: "memory");
            const unsigned og = xb_add(&bar[XB_TOP], 1u);
            const unsigned tg = og / nx;
            if (og + 1u == (tg + 1u) * nx) xb_add(&bar[XB_TOPGEN], 1u);
            else XB_SPIN(xb_ld(&bar[XB_TOPGEN]) == tg, bar);
            __builtin_amdgcn_fence(__ATOMIC_ACQUIRE, "agent");
            xb_add(&bar[XB_XGEN(b.x)], 1u);
            asm volatile("s_waitcnt vmcnt(0)" ::: "memory");
        } else {
            XB_SPIN(xb_ld(&bar[XB_XGEN(b.x)]) == gen, bar);
            __builtin_amdgcn_fence(__ATOMIC_ACQUIRE, "agent");
            asm volatile("s_waitcnt vmcnt(0)" ::: "memory");
        }
    }
    __syncthreads();
}

__global__ void __launch_bounds__(NTHREADS) hybrid_fwd(Args args) {
    extern __shared__ __attribute__((aligned(16))) unsigned char lds_raw[];
    LAS unsigned char* lds = (LAS unsigned char*)lds_raw;
    cg::grid_group grid = cg::this_grid();
    unsigned char* ws = args.ws;
    volatile LAS unsigned* MISC = (volatile LAS unsigned*)(lds + MISC_OFF);
    if (threadIdx.x < 16) MISC[threadIdx.x] = 0u;
    __syncthreads();
    XcdBarrier bar = xcd_barrier_post((unsigned*)(ws + WS_BAR), MISC + 8);
    if (args.ph_hi > 1000) grid.sync();
    Ctx C; C.PROJ = (bf16_t*)(ws + WS_PROJ); C.QB = (bf16_t*)(ws + WS_QB); C.KVB = (bf16_t*)(ws + WS_KVB); C.Y = (bf16_t*)(ws + WS_Y); C.U = (bf16_t*)(ws + WS_U);
    C.SSQ = (float*)(ws + WS_SSQ); C.COSA = (const float*)(ws + WS_COSA); C.SINA = (const float*)(ws + WS_SINA); C.COSB = (const float*)(ws + WS_COSB); C.SINB = (const float*)(ws + WS_SINB);
    const int lo = args.ph_lo, hi = args.ph_hi;
#define IN(k) (lo <= (k) && (k) < hi)
#define SEAM(k) do { if (IN(k) && IN((k) + 1)) xcd_barrier(bar); } while (0)
#define GSYNC() xcd_barrier(bar)
#if FAST_GEMM
#define RUN_GEMM(KIND, g) RUN_GEMM_C(KIND, g, C)
#define RUN_GEMM_C(KIND, g, CC) do { pg8::StaticOrder S_; S_.init((g).M, (g).N, (int)gridDim.x, (int)blockIdx.x); pg8::EpiK<KIND> E_{CC}; \
        pg8::gemm_phase<pg8::EpiK<KIND>, pg8::StaticOrder, (KIND == EK_UP ? UP_ALIGN : GEMM_ALIGN), GEMM_SP2>(lds, (g), S_, E_); __syncthreads(); } while (0)
#else
#define RUN_GEMM(KIND, g) naive_gemm<KIND>((g), C)
#endif
#ifndef PROBE_MASK
#define PROBE_MASK 0
#endif
#ifndef PROBE_T
#define PROBE_T -1
#endif
#define TIMED(id, stmt) do { unsigned long long t0_ = 0; if (PROBE_T == (id)) t0_ = __builtin_amdgcn_s_memrealtime(); stmt; \
        if (PROBE_T == (id)) { __syncthreads(); const unsigned long long t1_ = __builtin_amdgcn_s_memrealtime(), dt_ = t1_ - t0_; while (__builtin_amdgcn_s_memrealtime() - t1_ < dt_) __builtin_amdgcn_s_sleep(4); } } while (0)
#define PH0() do { if (IN(0)) { TIMED(0, p0_prologue(args, lds)); } } while (0)
#define PH1() do { if (IN(1)) { const GemmDesc g{(const bf16_t*)(ws + WS_HB), (const bf16_t*)(ws + WS_BTIN), T, 4096, DM, DM, 0, 0, 0}; TIMED(10, RUN_GEMM(EK_PROJ, g)); TIMED(11, kr_phase(args, C, lds)); } } while (0)
#if FAST_ATTN_A
#define PH2A() fast_attn_a(args, (LAS char*)lds)
#define PH3A() merge_a(args)
#else
#define PH2A() naive_attn_a(args)
#define PH3A() do {} while (0)
#endif
#if FAST_ATTN_B
#define PH3B() fast_attn_b(args, (LAS char*)lds)
#else
#define PH3B() naive_attn_b(args)
#endif
#define PH2() do { if (IN(2)) { const GemmDesc g{(const bf16_t*)(ws + WS_PROJ), (const bf16_t*)(ws + WS_BTUP), T, NUP, LAT, NPROJ, 6, 3072 * 2, 3584 * 2}; TIMED(22, { TIMED(20, RUN_GEMM(EK_UP, g)); TIMED(21, PH2A()); }); } } while (0)
#define PH3() do { if (IN(3)) { TIMED(30, PH3A()); TIMED(31, PH3B()); } } while (0)
#define PH4() do { if (IN(4)) { const GemmDesc g{(const bf16_t*)(ws + WS_HB), (const bf16_t*)(ws + WS_BTOUT), T, DM, DM, DM, 0, 0, 0}; TIMED(4, RUN_GEMM(EK_OUT, g)); } } while (0)
#define PH5() do { if (IN(5)) { TIMED(5, row_pass1(args)); } } while (0)
#define PH6() do { if (IN(6)) { const GemmDesc g{(const bf16_t*)(ws + WS_HB), (const bf16_t*)(ws + WS_BTFU), T, FF, DM, DM, 0, 0, 0}; TIMED(6, RUN_GEMM(EK_FU, g)); } } while (0)
#define PH7() do { if (IN(7)) { const GemmDesc g{(const bf16_t*)(ws + WS_U), (const bf16_t*)(ws + WS_BTFD), T, DM, FF, FF, 0, 0, 0}; Ctx C7 = C; C7.Y = (bf16_t*)(ws + WS_HB); TIMED(7, RUN_GEMM_C(EK_OUT, g, C7)); } } while (0)
    PH0();
#if (PROBE_MASK >> 0) & 1
    GSYNC(); PH0();
#endif
    SEAM(0);
    PH1();
    SEAM(1);
    PH2();
    SEAM(2);
    PH3();
#if (PROBE_MASK >> 2) & 1
    GSYNC(); PH2(); GSYNC(); PH3();
#endif
#if (PROBE_MASK >> 8) & 1
    GSYNC(); PH2A(); GSYNC(); PH3A();
#endif
#if (PROBE_MASK >> 9) & 1
    GSYNC(); PH3B();
#endif
#if (PROBE_MASK >> 10) & 1
    for (int i_ = 0; i_ < 20; ++i_) GSYNC();
#endif
    SEAM(3);
    PH4();
#if (PROBE_MASK >> 4) & 1
    GSYNC(); PH4();
#endif
    SEAM(4);
    PH5();
#if (PROBE_MASK >> 5) & 1
    GSYNC(); PH5();
#endif
    SEAM(5);
#if (PROBE_MASK >> 11) & 1
    { const unsigned long long t0_ = __builtin_amdgcn_s_memrealtime(); while (__builtin_amdgcn_s_memrealtime() - t0_ < 10000ull) __builtin_amdgcn_s_sleep(16); }
#endif
    PH6();
#if (PROBE_MASK >> 6) & 1
    GSYNC(); PH6();
#endif
    SEAM(6);
    PH7();
#if (PROBE_MASK >> 7) & 1
    GSYNC(); PH7();
#endif
    SEAM(7);
    if (IN(8)) { TIMED(8, row_pass2(args)); }
}

extern "C" void kernel_launch(void* const* d_in, const int* in_sizes, int n_in, void* d_out, int out_size, void* d_ws, size_t ws_size, hipStream_t stream) {
    static int grid = 0;
    if (grid == 0) {
        if (n_in != 14 || in_sizes[0] != T * DM || out_size != T * DM || ws_size < WS_END) { fprintf(stderr, "kernel_launch: unexpected shapes / workspace (n_in %d, ws %zu, need %zu)\n", n_in, ws_size, (size_t)WS_END); grid = -1; return; }
        int dev = 0, cus = 0, per_cu = 0;
        (void)hipGetDevice(&dev); (void)hipDeviceGetAttribute(&cus, hipDeviceAttributeMultiprocessorCount, dev);
        if (hipFuncSetAttribute((const void*)hybrid_fwd, hipFuncAttributeMaxDynamicSharedMemorySize, LDS_BYTES) != hipSuccess) { fprintf(stderr, "kernel_launch: hipFuncSetAttribute failed\n"); grid = -1; return; }
        if (hipOccupancyMaxActiveBlocksPerMultiprocessor(&per_cu, (const void*)hybrid_fwd, NTHREADS, LDS_BYTES) != hipSuccess || per_cu < 1) { fprintf(stderr, "kernel_launch: occupancy query failed (%d)\n", per_cu); (void)hipGetLastError(); per_cu = 1; }
        grid = cus * (per_cu > 1 ? 1 : per_cu);
        if (grid <= 0) grid = 256;
    }
    if (grid < 0) return;
    Args a{};
    a.x = (const float*)d_in[0]; a.pos = (const int*)d_in[1]; a.g_pre = (const float*)d_in[2]; a.g_post = (const float*)d_in[3]; a.w_in = (const float*)d_in[4];
    a.g_q = (const float*)d_in[5]; a.g_kv = (const float*)d_in[6]; a.w_uq = (const float*)d_in[7]; a.w_ukv = (const float*)d_in[8]; a.w_out = (const float*)d_in[9];
    a.g_pre2 = (const float*)d_in[10]; a.g_post2 = (const float*)d_in[11]; a.w_up = (const float*)d_in[12]; a.w_down = (const float*)d_in[13];
    a.out = (float*)d_out; a.ws = (unsigned char*)d_ws;
    if (hipMemsetAsync((char*)d_ws + WS_BAR, 0, 16 * 1024 + 2048, stream) != hipSuccess) { fprintf(stderr, "kernel_launch: memset of the barrier words failed\n"); return; }
    constexpr int NPH = 9;
    for (int li = 0; li < MK_N_LAUNCHES; ++li) {
        a.ph_lo = (MK_N_LAUNCHES == 1) ? 0 : li; a.ph_hi = (MK_N_LAUNCHES == 1) ? NPH : li + 1;
        void* kargs[] = {&a};
        const hipError_t e = hipLaunchCooperativeKernel((const void*)hybrid_fwd, dim3(grid), dim3(NTHREADS), kargs, LDS_BYTES, stream);
        if (e != hipSuccess) { fprintf(stderr, "kernel_launch: cooperative launch %d failed: %s (grid %d)\n", li, hipGetErrorString(e), grid); break; }
    }
}
```

```cpp
#include <hip/hip_runtime.h>
#include <hip/hip_cooperative_groups.h>
#include <cstdio>
#include <cstdint>
namespace cg = cooperative_groups;

#ifndef MK_N_LAUNCHES
#define MK_N_LAUNCHES 1
#endif
#ifndef FAST_GEMM
#define FAST_GEMM 1
#endif
#ifndef GEMM_SP2
#define GEMM_SP2 true
#endif
#ifndef GEMM_ALIGN
#define GEMM_ALIGN true
#endif
#ifndef REV_OUT
#define REV_OUT 1
#endif
#ifndef WGM_OTHER
#define WGM_OTHER 4
#endif
#ifndef UP_ALIGN
#define UP_ALIGN true
#endif
#ifndef ATTN_A_SEAM
#define ATTN_A_SEAM 1
#endif
#ifndef ATTN_A_SKEW
#define ATTN_A_SKEW 1
#endif
#ifndef FAST_ATTN_A
#define FAST_ATTN_A 1
#endif
#ifndef FAST_ATTN_B
#define FAST_ATTN_B 1
#endif

#define LAS __attribute__((address_space(3)))
typedef unsigned short bf16_t;
typedef short bf16x8 __attribute__((ext_vector_type(8)));
typedef short s16x4 __attribute__((ext_vector_type(4)));
typedef float f32x4 __attribute__((ext_vector_type(4)));
typedef float f32x16 __attribute__((ext_vector_type(16)));
typedef unsigned u32x4 __attribute__((ext_vector_type(4)));
typedef unsigned u32x2 __attribute__((ext_vector_type(2)));

constexpr int NB = 4, SEQ = 4096, T = NB * SEQ, DM = 2048, NPROJ = 4352  , FF = 8192, NUP = 3584, LAT = 512;
constexpr float EPS = 1e-6f, LOG2E = 1.4426950408889634f;
constexpr float C2A = 0.08838834764831845f * LOG2E;
constexpr float C2B = 0.07216878364870323f * LOG2E;
constexpr int NTHREADS = 512, NWAVES = 8;
constexpr int LDS_BYTES = 155648, MISC_OFF = LDS_BYTES - 64;

constexpr size_t MiB = 1u << 20;
constexpr size_t WS_SSQ = 0;
constexpr size_t WS_BAR = 128 * 1024;
constexpr size_t WS_QCTR = WS_BAR + 16 * 1024;
constexpr size_t WS_LSE = 256 * 1024;
constexpr size_t WS_COSA = 2 * MiB, WS_SINA = 3 * MiB;
constexpr size_t WS_COSB = 4 * MiB, WS_SINB = 6 * MiB;
constexpr size_t WS_BTIN = 8 * MiB;
constexpr size_t WS_BTUP = 25 * MiB;
constexpr size_t WS_BTOUT = 29 * MiB;
constexpr size_t WS_BTFU = 37 * MiB;
constexpr size_t WS_BTFD = 69 * MiB;
constexpr size_t WS_HB = 101 * MiB;
constexpr size_t WS_Y = 165 * MiB;
constexpr size_t WS_PROJ = 229 * MiB;
constexpr size_t WS_QB = 365 * MiB;
constexpr size_t WS_KVB = 413 * MiB;
constexpr size_t WS_U = 229 * MiB;
constexpr size_t WS_END = 485 * MiB;

struct Args {
    const float* x; const int* pos; const float* g_pre; const float* g_post; const float* w_in; const float* g_q; const float* g_kv;
    const float* w_uq; const float* w_ukv; const float* w_out; const float* g_pre2; const float* g_post2; const float* w_up; const float* w_down;
    float* out; unsigned char* ws; int ph_lo, ph_hi;
};

__device__ __forceinline__ unsigned cvt_pk_bf16(float lo, float hi) { unsigned r; asm volatile("v_cvt_pk_bf16_f32 %0, %1, %2" : "=v"(r) : "v"(lo), "v"(hi)); return r; }
__device__ __forceinline__ float bf_lo(unsigned w) { return __uint_as_float(w << 16); }
__device__ __forceinline__ float bf_hi(unsigned w) { return __uint_as_float(w & 0xffff0000u); }
__device__ __forceinline__ float bf2f(bf16_t h) { return __uint_as_float((unsigned)h << 16); }
__device__ __forceinline__ float wave_sum(float v) {
#pragma unroll
    for (int o = 1; o < 64; o <<= 1) v += __shfl_xor(v, o);
    return v;
}
#ifndef EPI_WT
#define EPI_WT 0
#endif
__device__ __forceinline__ void store8(bf16_t* p, const float* v) {
    u32x4 w; w.x = cvt_pk_bf16(v[0], v[1]); w.y = cvt_pk_bf16(v[2], v[3]); w.z = cvt_pk_bf16(v[4], v[5]); w.w = cvt_pk_bf16(v[6], v[7]);
#if EPI_WT
    asm volatile("global_store_dwordx4 %0, %1, off sc1\n\ts_nop 1" :: "v"(p), "v"(w) : "memory");
#else
    *(u32x4*)p = w;
#endif
}
__device__ __forceinline__ void load8f(const bf16_t* p, float* v) {
    const u32x4 w = *(const u32x4*)p;
    v[0] = bf_lo(w.x); v[1] = bf_hi(w.x); v[2] = bf_lo(w.y); v[3] = bf_hi(w.y); v[4] = bf_lo(w.z); v[5] = bf_hi(w.z); v[6] = bf_lo(w.w); v[7] = bf_hi(w.w);
}

struct Ctx {
    bf16_t *PROJ, *QB, *KVB, *Y, *U;
    float* SSQ; const float *COSA, *SINA, *COSB, *SINB;
};
enum { EK_PROJ = 0, EK_UP = 1, EK_OUT = 2, EK_FU = 3 };
__device__ __forceinline__ void rope8(float* v, const float* cs, const float* sn) {
    const f32x4 c = *(const f32x4*)cs, s = *(const f32x4*)sn;
#pragma unroll
    for (int j = 0; j < 4; ++j) { const float a = v[j], b = v[4 + j]; v[j] = a * c[j] - b * s[j]; v[4 + j] = b * c[j] + a * s[j]; }
}
template <int KIND> __device__ __forceinline__ float epi8(const Ctx& C, int row, int col, float* v, float rs_q, float rs_kv) {
    if constexpr (KIND == EK_PROJ) {
        const int pn = col >> 8; float ss = 0.f;
        if (pn < 8) {
            const int c = col & 127;
            if (c < 32) { const int i0 = 4 * (c >> 3); rope8(v, C.COSA + (size_t)row * 16 + i0, C.SINA + (size_t)row * 16 + i0); }
            if (pn < 4) {
#pragma unroll
                for (int j = 0; j < 8; ++j) v[j] *= C2A;
            }
        } else if (pn >= 12 && pn < 16) {
#pragma unroll
            for (int j = 0; j < 8; ++j) ss += v[j] * v[j];
        } else if (pn == 16) {
            const int c = col - 4096;
            if (c < 64) { const int i0 = 16 * (c >> 5) + 4 * ((c & 31) >> 3); rope8(v, C.COSB + (size_t)row * 32 + i0, C.SINB + (size_t)row * 32 + i0); }
        }
        store8(C.PROJ + (size_t)row * NPROJ + col, v);
        return ss;
    } else if constexpr (KIND == EK_UP) {
        if (col < 1536) {
            if (col >= 1024) { const int P = (col - 1024) & 63; const int i0 = 16 * (P >> 5) + 4 * ((P & 31) >> 3); rope8(v, C.COSB + (size_t)row * 32 + i0, C.SINB + (size_t)row * 32 + i0); }
            const float sc = rs_q * C2B;
#pragma unroll
            for (int j = 0; j < 8; ++j) v[j] *= sc;
            store8(C.QB + (size_t)row * 1536 + col, v);
        } else {
#pragma unroll
            for (int j = 0; j < 8; ++j) v[j] *= rs_kv;
            store8(C.KVB + (size_t)row * 2048 + (col - 1536), v);
        }
        return 0.f;
    } else if constexpr (KIND == EK_OUT) {
        store8(C.Y + (size_t)row * DM + col, v); return 0.f;
    } else {
#pragma unroll
        for (int j = 0; j < 8; ++j) { const float r = fmaxf(v[j], 0.f); v[j] = r * r; }
        store8(C.U + (size_t)row * FF + col, v); return 0.f;
    }
}
__device__ __forceinline__ float rs_from_ssq(float ss) { return 1.0f / sqrtf(ss * (1.0f / LAT) + EPS); }

struct GemmDesc { const bf16_t* A; const bf16_t* Bt; int M, N, K, lda; int split_pn; int aoff0, aoff1;
    __device__ __forceinline__ int aoff(int pn) const { return pn < split_pn ? aoff0 : aoff1; } };
template <int KIND> __device__ void naive_gemm(const GemmDesc g, const Ctx& C) {
    const long total = (long)g.M * (g.N / 8);
    for (long idx = (long)blockIdx.x * NTHREADS + threadIdx.x; idx < total; idx += (long)gridDim.x * NTHREADS) {
        const int row = (int)(idx % g.M), col = (int)(idx / g.M) * 8;
        const bf16_t* a = (const bf16_t*)((const char*)g.A + g.aoff(col >> 8)) + (size_t)row * g.lda;
        const bf16_t* b = g.Bt + (size_t)col * g.K;
        float acc[8] = {0.f, 0.f, 0.f, 0.f, 0.f, 0.f, 0.f, 0.f};
        for (int k = 0; k < g.K; k += 8) {
            float av[8]; load8f(a + k, av);
#pragma unroll
            for (int j = 0; j < 8; ++j) { float bv[8]; load8f(b + (size_t)j * g.K + k, bv);
#pragma unroll
                for (int e = 0; e < 8; ++e) acc[j] += av[e] * bv[e]; }
        }
        float rq = 0.f, rkv = 0.f;
        if constexpr (KIND == EK_UP) { rq = rs_from_ssq(C.SSQ[row * 2]); rkv = rs_from_ssq(C.SSQ[row * 2 + 1]); }
        const float ss = epi8<KIND>(C, row, col, acc, rq, rkv);
        if constexpr (KIND == EK_PROJ) { const int pn = col >> 8; if (pn >= 12 && pn < 16) atomicAdd(C.SSQ + row * 2 + (pn >= 14 ? 1 : 0), ss); }
    }
}

namespace pg8 {
#define PG8_LAS __attribute__((address_space(3)))
constexpr int BM = 256, BK = 64, HALF = 128, HTB = HALF * BK * 2  , STAGE_BYTES = 8 * HTB, NXCD = 8, WGM = 4;
__host__ __device__ __forceinline__ int lds_byte(int r, int c) { const int st = (r >> 4) * 2 + (c >> 5), rr = r & 15, cc = c & 31, ob = rr * 64 + cc * 2; return st * 1024 + (ob ^ (((ob >> 9) & 1) << 5)); }
__host__ __device__ __forceinline__ void stage_rc(int b, int& R, int& C) { const int st = b / 1024, sb = b % 1024, swz = sb ^ (((sb >> 9) & 1) << 5); R = (st >> 1) * 16 + swz / 64; C = (st & 1) * 32 + (swz % 64) / 2; }
__host__ __device__ __forceinline__ int perm32(int rho) { const int n = rho >> 4, i = rho & 15; return 8 * (i >> 2) + 4 * n + (i & 3); }
struct Unit { int pm, pn; };
typedef GemmDesc Gemm;
struct StaticOrder {
    int nM, nN, nwg, G, c, wgm, rev;
    __host__ __device__ void init(int M, int N, int G_, int c_) { nM = M / BM; nN = N / BM; nwg = nM * nN; G = G_; c = c_; wgm = WGM; rev = 0; }
    __host__ __device__ bool next(int i, Unit& u) const {
        if ((long)i * G + c >= nwg) return false;
        const int ii = (rev && nwg % G == 0) ? (nwg / G - 1 - i) : i;
        const long L = (long)ii * G + c;
        int wgid = (int)L; { const int q = nwg / NXCD, r = nwg % NXCD, xcd = wgid % NXCD, off = wgid / NXCD; wgid = (xcd < r ? xcd * (q + 1) : r * (q + 1) + (xcd - r) * q) + off; }
        const int nig = wgm * nN, gid = wgid / nig, fm = gid * wgm, gsz = (nM - fm) < wgm ? (nM - fm) : wgm;
        u.pm = fm + ((wgid % nig) % gsz); u.pn = (wgid % nig) / gsz; return true;
    }
    __device__ __forceinline__ void a_ready(const Unit&) const {}
    __device__ __forceinline__ void done(const Unit&) const {}
};
template <int KIND> struct EpiK {
    static constexpr bool PERM = true, AFTER_DRAIN = false;
    Ctx C;
    __device__ __forceinline__ void operator()(const f32x4 (&acc)[2][2][4][2], const Unit& u, int wr, int wc, int fr, int fq) const {
#pragma unroll
        for (int ai = 0; ai < 2; ++ai)
#pragma unroll
            for (int m = 0; m < 4; ++m) {
                const int row = u.pm * BM + ai * HALF + wr * 64 + m * 16 + fr;
                float rq = 0.f, rkv = 0.f, ssum = 0.f;
                if constexpr (KIND == EK_UP) { if (u.pn < 6) rq = rs_from_ssq(C.SSQ[row * 2]); else rkv = rs_from_ssq(C.SSQ[row * 2 + 1]); }
#pragma unroll
                for (int bj = 0; bj < 2; ++bj) {
                    const int col = u.pn * BM + bj * HALF + wc * 32 + fq * 8;
                    float v[8] = {acc[ai][bj][m][0][0], acc[ai][bj][m][0][1], acc[ai][bj][m][0][2], acc[ai][bj][m][0][3], acc[ai][bj][m][1][0], acc[ai][bj][m][1][1], acc[ai][bj][m][1][2], acc[ai][bj][m][1][3]};
                    ssum += epi8<KIND>(C, row, col, v, rq, rkv);
                }
                if constexpr (KIND == EK_PROJ) {
                    if (u.pn >= 12 && u.pn < 16) { ssum += __shfl_xor(ssum, 16); ssum += __shfl_xor(ssum, 32); if (fq == 0) atomicAdd(C.SSQ + row * 2 + (u.pn >= 14 ? 1 : 0), ssum); }
                }
            }
    }
};
template <class Epi, class Sched, bool ALIGN_EPI = false, bool SP2 = false>
__device__ __forceinline__ void gemm_phase(PG8_LAS unsigned char* lds, const Gemm g, const Sched& S, const Epi& E) {
    const int tid = threadIdx.x, wid = __builtin_amdgcn_readfirstlane(tid >> 6), lane = tid & 63, wr = wid >> 2, wc = wid & 3, fr = lane & 15, fq = lane >> 4;
    const int K = g.K, nt = K / BK;
    unsigned voffA[2], voffB[2];
#pragma unroll
    for (int i = 0; i < 2; ++i) { int R, C; stage_rc(tid * 16 + i * 8192, R, C); const int Rb = Epi::PERM ? ((R & ~31) + perm32(R & 31)) : R;
        voffA[i] = (unsigned)(R * g.lda + C) * 2u; voffB[i] = (unsigned)(Rb * K + C) * 2u; }
    const size_t kstep = (size_t)(BK * 2);
    const size_t hstepA = (size_t)HALF * g.lda * 2, hstepB = (size_t)HALF * K * 2;
    const size_t tstepA = 2 * hstepA, tstepB = 2 * hstepB;
    const unsigned ldsw = (unsigned)wid * 1024u;
    const int aoff = lds_byte(wr * 64 + fr, fq * 8), boff = lds_byte(wc * 32 + fr, fq * 8);
#define PG8_SA(b, h) (((b) * 2 + (h)) * HTB)
#define PG8_SB(b, h) ((4 + (b) * 2 + (h)) * HTB)
#define PG8_STAGE(bufoff, gbase, voff) do { _Pragma("unroll") for (int _i = 0; _i < 2; ++_i) \
        __builtin_amdgcn_global_load_lds((const unsigned*)((const char*)(gbase) + (voff)[_i]), (PG8_LAS unsigned*)(lds + (bufoff) + ldsw + _i * 8192), 16, 0, 0); } while (0)
#define PG8_LDA(dst, b, h) do { _Pragma("unroll") for (int m = 0; m < 4; ++m) _Pragma("unroll") for (int k = 0; k < 2; ++k) dst[m][k] = *(const PG8_LAS bf16x8*)(lds + PG8_SA(b, h) + aoff + m * 2048 + k * 1024); } while (0)
#define PG8_LDB(dst, b, h) do { _Pragma("unroll") for (int n = 0; n < 2; ++n) _Pragma("unroll") for (int k = 0; k < 2; ++k) dst[n][k] = *(const PG8_LAS bf16x8*)(lds + PG8_SB(b, h) + boff + n * 2048 + k * 1024); } while (0)
#define PG8_MMA(ai, bj, At, Bt) do { __builtin_amdgcn_s_setprio(1); _Pragma("unroll") for (int m = 0; m < 4; ++m) _Pragma("unroll") for (int n = 0; n < 2; ++n) _Pragma("unroll") for (int k = 0; k < 2; ++k) \
        acc[ai][bj][m][n] = __builtin_amdgcn_mfma_f32_16x16x32_bf16(Bt[n][k], At[m][k], acc[ai][bj][m][n], 0, 0, 0); __builtin_amdgcn_s_setprio(0); } while (0)
#define PG8_WAIT_V(n) asm volatile("s_waitcnt vmcnt(" #n ")" ::: "memory")
#define PG8_WAIT_L(n) asm volatile("s_waitcnt lgkmcnt(" #n ")" ::: "memory")
#define PG8_BAR __builtin_amdgcn_s_barrier()
#define PG8_SCHED __builtin_amdgcn_sched_barrier(0)
    Unit cur, nxt; int ui = 0;
    if (!S.next(0, cur)) return;
    f32x4 acc[2][2][4][2];
#pragma unroll
    for (int a = 0; a < 2; ++a)
#pragma unroll
        for (int b = 0; b < 2; ++b)
#pragma unroll
            for (int m = 0; m < 4; ++m)
#pragma unroll
                for (int n = 0; n < 2; ++n) acc[a][b][m][n] = (f32x4){0.f, 0.f, 0.f, 0.f};
    bf16x8 At[4][2], B0[2][2], B1[2][2];
    const char* cA = (const char*)g.A + g.aoff(cur.pn) + (size_t)cur.pm * tstepA; const char* cB = (const char*)g.Bt + (size_t)cur.pn * tstepB;
    S.a_ready(cur);
    if constexpr (SP2) {
        PG8_STAGE(PG8_SB(0, 0), cB, voffB); PG8_STAGE(PG8_SB(0, 1), cB + hstepB, voffB); PG8_STAGE(PG8_SA(0, 0), cA, voffA); PG8_STAGE(PG8_SA(0, 1), cA + hstepA, voffA);
        if (wr == 1) PG8_BAR;
        PG8_WAIT_V(2); PG8_BAR;
        PG8_STAGE(PG8_SB(1, 0), cB + kstep, voffB); PG8_STAGE(PG8_SA(1, 0), cA + kstep, voffA); PG8_STAGE(PG8_SB(1, 1), cB + hstepB + kstep, voffB);
        PG8_WAIT_V(6); PG8_BAR;
    } else {
        PG8_STAGE(PG8_SB(0, 0), cB, voffB); PG8_STAGE(PG8_SA(0, 0), cA, voffA); PG8_STAGE(PG8_SB(0, 1), cB + hstepB, voffB); PG8_STAGE(PG8_SA(0, 1), cA + hstepA, voffA);
        if (wr == 1) PG8_BAR;
        PG8_WAIT_V(4); PG8_BAR;
        PG8_STAGE(PG8_SB(1, 0), cB + kstep, voffB); PG8_STAGE(PG8_SA(1, 0), cA + kstep, voffA); PG8_STAGE(PG8_SB(1, 1), cB + hstepB + kstep, voffB);
        PG8_WAIT_V(6); PG8_BAR;
    }
    for (;;) {
        const bool has_next = S.next(ui + 1, nxt);
        const char* nA = has_next ? (const char*)g.A + g.aoff(nxt.pn) + (size_t)nxt.pm * tstepA : cA; const char* nB = has_next ? (const char*)g.Bt + (size_t)nxt.pn * tstepB : cB;
        for (int t = 0; t < nt; t += 2) {
            const bool last = (t == nt - 2);
            const char* a1 = cA + (size_t)(t + 1) * kstep;
            const char* a2 = last ? nA : cA + (size_t)(t + 2) * kstep; const char* b2 = last ? nB : cB + (size_t)(t + 2) * kstep;
            const char* a3 = a2 + kstep; const char* b3 = b2 + kstep;
            if (last && has_next) S.a_ready(nxt);
            if constexpr (SP2) {
            PG8_LDB(B0, 0, 0); PG8_LDB(B1, 0, 1); PG8_SCHED; PG8_LDA(At, 0, 0); PG8_STAGE(PG8_SA(1, 1), a1 + hstepA, voffA);
            PG8_WAIT_V(8); PG8_WAIT_L(0); PG8_BAR; PG8_MMA(0, 0, At, B0); PG8_MMA(0, 1, At, B1); PG8_BAR; PG8_SCHED;
            PG8_LDA(At, 0, 1); PG8_STAGE(PG8_SB(0, 0), b2, voffB); PG8_STAGE(PG8_SB(0, 1), b2 + hstepB, voffB); PG8_STAGE(PG8_SA(0, 0), a2, voffA);
            PG8_WAIT_V(8); PG8_WAIT_L(0); PG8_BAR; PG8_MMA(1, 0, At, B0); PG8_MMA(1, 1, At, B1); PG8_BAR; PG8_SCHED;
            PG8_LDB(B0, 1, 0); PG8_LDB(B1, 1, 1); PG8_SCHED; PG8_LDA(At, 1, 0); PG8_STAGE(PG8_SA(0, 1), a2 + hstepA, voffA);
            PG8_WAIT_V(8); PG8_WAIT_L(0); PG8_BAR; PG8_MMA(0, 0, At, B0); PG8_MMA(0, 1, At, B1); PG8_BAR; PG8_SCHED;
            PG8_LDA(At, 1, 1); PG8_STAGE(PG8_SB(1, 0), b3, voffB); PG8_STAGE(PG8_SB(1, 1), b3 + hstepB, voffB); PG8_STAGE(PG8_SA(1, 0), a3, voffA);
            PG8_WAIT_V(8); PG8_WAIT_L(0); PG8_BAR; PG8_MMA(1, 0, At, B0); PG8_MMA(1, 1, At, B1); PG8_BAR; PG8_SCHED;
            } else {
            PG8_LDB(B0, 0, 0); PG8_SCHED; PG8_LDA(At, 0, 0); PG8_STAGE(PG8_SA(1, 1), a1 + hstepA, voffA);
            PG8_WAIT_L(8); PG8_BAR; PG8_WAIT_L(0); PG8_MMA(0, 0, At, B0); PG8_BAR; PG8_SCHED;
            PG8_LDB(B1, 0, 1); PG8_STAGE(PG8_SB(0, 0), b2, voffB);
            PG8_BAR; PG8_WAIT_L(0); PG8_MMA(0, 1, At, B1); PG8_BAR;
            PG8_LDA(At, 0, 1); PG8_STAGE(PG8_SA(0, 0), a2, voffA);
            PG8_BAR; PG8_WAIT_L(0); PG8_MMA(1, 0, At, B0); PG8_BAR; PG8_SCHED;
            PG8_STAGE(PG8_SB(0, 1), b2 + hstepB, voffB);
            PG8_WAIT_V(6); PG8_BAR; PG8_MMA(1, 1, At, B1); PG8_BAR;
            PG8_LDB(B0, 1, 0); PG8_SCHED; PG8_LDA(At, 1, 0); PG8_STAGE(PG8_SA(0, 1), a2 + hstepA, voffA);
            PG8_WAIT_L(8); PG8_BAR; PG8_WAIT_L(0); PG8_MMA(0, 0, At, B0); PG8_BAR; PG8_SCHED;
            PG8_LDB(B1, 1, 1); PG8_STAGE(PG8_SB(1, 0), b3, voffB);
            PG8_BAR; PG8_WAIT_L(0); PG8_MMA(0, 1, At, B1); PG8_BAR;
            PG8_LDA(At, 1, 1); PG8_STAGE(PG8_SA(1, 0), a3, voffA);
            PG8_BAR; PG8_WAIT_L(0); PG8_MMA(1, 0, At, B0); PG8_BAR; PG8_SCHED;
            PG8_STAGE(PG8_SB(1, 1), b3 + hstepB, voffB);
            PG8_WAIT_V(6); PG8_BAR; PG8_MMA(1, 1, At, B1); PG8_BAR;
            }
        }
        if constexpr (ALIGN_EPI) { if (wr == 0) PG8_BAR; }
        if constexpr (!Epi::AFTER_DRAIN) { E(acc, cur, wr, wc, fr, fq); S.done(cur); }
        if (!has_next) break;
#pragma unroll
        for (int a = 0; a < 2; ++a)
#pragma unroll
            for (int b = 0; b < 2; ++b)
#pragma unroll
                for (int m = 0; m < 4; ++m)
#pragma unroll
                    for (int n = 0; n < 2; ++n) acc[a][b][m][n] = (f32x4){0.f, 0.f, 0.f, 0.f};
        cur = nxt; cA = nA; cB = nB; ++ui;
        if constexpr (ALIGN_EPI) { if (wr == 1) PG8_BAR; }
    }
    PG8_WAIT_V(0);
    if constexpr (!ALIGN_EPI) { if (wr == 0) PG8_BAR; }
    PG8_BAR;
    if constexpr (Epi::AFTER_DRAIN) { E.fused(acc, cur, wr, wc, fr, fq, lds, wid, lane); S.done(cur); }
#undef PG8_SA
#undef PG8_SB
#undef PG8_STAGE
#undef PG8_LDA
#undef PG8_LDB
#undef PG8_MMA
#undef PG8_WAIT_V
#undef PG8_WAIT_L
#undef PG8_BAR
#undef PG8_SCHED
}
}

__device__ __forceinline__ int permA(int p) { return 16 * ((p >> 2) & 1) + 4 * (p >> 3) + (p & 3); }
__device__ __forceinline__ int permB(int P) { const int g = P >> 5, p = P & 31; return 32 * ((p >> 2) & 1) + 16 * g + 4 * (p >> 3) + (p & 3); }
struct TrItem { const float* W; const float* gain; bf16_t* WT; int N, K, k0, n0, src, n0src; bool fast; };
__device__ __forceinline__ TrItem tr_decode(const Args& a, int it, int lane) {
    constexpr int I_IN = (NPROJ / 64) * (DM / 64), I_UP = (NUP / 64) * (LAT / 64), I_OUT = (DM / 64) * (DM / 64), I_FU = (FF / 64) * (DM / 64);
    unsigned char* ws = a.ws; TrItem P; int r = it; P.gain = nullptr;
    if (r < I_IN) { const int nb = r % (NPROJ / 64), kb = r / (NPROJ / 64), n = nb * 64 + lane; int src;
        if (n < 2048) { const int c = n & 127; src = (n & ~127) + (c < 32 ? permA(c) : c); } else if (n < 4096) src = n; else { const int Pp = n - 4096; src = Pp < 64 ? 4096 + permB(Pp) : -1; }
        P.W = a.w_in; P.N = 4160; P.k0 = kb * 64; P.src = src; P.WT = (bf16_t*)(ws + WS_BTIN); P.K = DM; P.n0 = nb * 64; }
    else if ((r -= I_IN) < I_UP) { const int nb = r % (NUP / 64), kb = r / (NUP / 64), n = nb * 64 + lane; P.k0 = kb * 64; P.WT = (bf16_t*)(ws + WS_BTUP); P.K = LAT; P.n0 = nb * 64;
        if (n < 1536) { int src; if (n < 1024) src = (n >> 7) * 192 + (n & 127); else { const int q = n - 1024; src = (q >> 6) * 192 + 128 + permB(q & 63); } P.W = a.w_uq; P.N = 1536; P.src = src; P.gain = a.g_q; }
        else { P.W = a.w_ukv; P.N = 2048; P.src = n - 1536; P.gain = a.g_kv; } }
    else if ((r -= I_UP) < I_OUT) { const int nb = r % (DM / 64), kb = r / (DM / 64); P.W = a.w_out; P.N = DM; P.k0 = kb * 64; P.src = nb * 64 + lane; P.WT = (bf16_t*)(ws + WS_BTOUT); P.K = DM; P.n0 = nb * 64; }
    else if ((r -= I_OUT) < I_FU) { const int nb = r % (FF / 64), kb = r / (FF / 64); P.W = a.w_up; P.N = FF; P.k0 = kb * 64; P.src = nb * 64 + lane; P.WT = (bf16_t*)(ws + WS_BTFU); P.K = DM; P.n0 = nb * 64; }
    else { r -= I_FU; const int nb = r % (DM / 64), kb = r / (DM / 64); P.W = a.w_down; P.N = DM; P.k0 = kb * 64; P.src = nb * 64 + lane; P.WT = (bf16_t*)(ws + WS_BTFD); P.K = FF; P.n0 = nb * 64; }
    P.n0src = __builtin_amdgcn_readfirstlane(P.src);
    P.fast = !P.gain && __all(P.src == P.n0src + lane);
    return P;
}
__device__ __forceinline__ void tr_load(const TrItem& P, float (&v)[64], int lane) {
    if (P.fast) { const int c4 = lane & 15, kq = lane >> 4;
#pragma unroll
        for (int i = 0; i < 16; ++i) { const f32x4 x = *(const f32x4*)(P.W + (size_t)(P.k0 + kq + 4 * i) * P.N + P.n0src + 4 * c4); v[4 * i] = x.x; v[4 * i + 1] = x.y; v[4 * i + 2] = x.z; v[4 * i + 3] = x.w; }
    } else {
#pragma unroll
        for (int kk = 0; kk < 64; ++kk) v[kk] = P.src >= 0 ? P.W[(size_t)(P.k0 + kk) * P.N + P.src] : 0.f;
    }
}
__device__ __forceinline__ void tr_to_lds(const TrItem& P, const float (&v)[64], LAS float* scr, int lane) {
    if (P.fast) { const int c4 = lane & 15, kq = lane >> 4;
#pragma unroll
        for (int i = 0; i < 16; ++i) { LAS float* d = scr + (kq + 4 * i) * 65 + 4 * c4; d[0] = v[4 * i]; d[1] = v[4 * i + 1]; d[2] = v[4 * i + 2]; d[3] = v[4 * i + 3]; }
    } else {
#pragma unroll
        for (int kk = 0; kk < 64; ++kk) scr[kk * 65 + lane] = P.gain ? v[kk] * P.gain[P.k0 + kk] : v[kk];
    }
    asm volatile("s_waitcnt lgkmcnt(0)" ::: "memory");
}
__device__ __forceinline__ void tr_store(const TrItem& P, LAS float* scr, int lane) {
    const int c = lane & 7;
#pragma unroll
    for (int j = 0; j < 8; ++j) { const int n = (lane >> 3) + 8 * j; const LAS float* s = scr + (8 * c) * 65 + n;
        u32x4 o; o.x = cvt_pk_bf16(s[0 * 65], s[1 * 65]); o.y = cvt_pk_bf16(s[2 * 65], s[3 * 65]); o.z = cvt_pk_bf16(s[4 * 65], s[5 * 65]); o.w = cvt_pk_bf16(s[6 * 65], s[7 * 65]);
        *(u32x4*)(P.WT + (size_t)(P.n0 + n) * P.K + P.k0 + 8 * c) = o; }
    asm volatile("s_waitcnt lgkmcnt(0)" ::: "memory");
}
#ifndef PROBE_T
#define PROBE_T -1
#endif
#define TB(id) unsigned long long tb_##id = 0; if (PROBE_T == (id)) tb_##id = __builtin_amdgcn_s_memrealtime();
#define TE(id) if (PROBE_T == (id)) { __syncthreads(); const unsigned long long t1_ = __builtin_amdgcn_s_memrealtime(), dt_ = t1_ - tb_##id; while (__builtin_amdgcn_s_memrealtime() - t1_ < dt_) __builtin_amdgcn_s_sleep(4); }
__device__ __forceinline__ void p0_prologue(const Args& a, LAS unsigned char* lds) {
    unsigned char* ws = a.ws;
    const int tid = threadIdx.x, lane = tid & 63, wave = tid >> 6;
    const int gw = blockIdx.x * NWAVES + wave, NGW = gridDim.x * NWAVES;
    const long gt = (long)blockIdx.x * NTHREADS + tid, NGT = (long)gridDim.x * NTHREADS;
    TB(1) { float* ssq = (float*)(ws + WS_SSQ); for (long i = gt; i < (long)T * 2; i += NGT) ssq[i] = 0.f; }
    { float* ca = (float*)(ws + WS_COSA); float* sa = (float*)(ws + WS_SINA); float* cb = (float*)(ws + WS_COSB); float* sb = (float*)(ws + WS_SINB);
      const float l2t = 18.931568569324174f;
      for (long i = gt; i < (long)T * 32; i += NGT) { const int t = (int)(i >> 5), f = (int)(i & 31); const float p = (float)a.pos[t];
          { const float inv = exp2f(-(float)(2 * f) * (1.0f / 64.0f) * l2t); const float ang = p * inv; cb[i] = cosf(ang); sb[i] = sinf(ang); }
          if (f < 16) { const float inv = exp2f(-(float)(2 * f) * (1.0f / 32.0f) * l2t); const float ang = p * inv; ca[t * 16 + f] = cosf(ang); sa[t * 16 + f] = sinf(ang); } } }
    TE(1)
    TB(2) { bf16_t* HB = (bf16_t*)(ws + WS_HB);
      int m = gw;
      if (m < T) { f32x4 v[8];
#pragma unroll
          for (int j = 0; j < 8; ++j) v[j] = ((const f32x4*)(a.x + (size_t)m * DM) + lane)[64 * j];
          for (;;) { const int mn = m + NGW; const bool more = mn < T; f32x4 vn[8];
              if (more) {
#pragma unroll
                  for (int j = 0; j < 8; ++j) vn[j] = ((const f32x4*)(a.x + (size_t)mn * DM) + lane)[64 * j]; }
              float s = 0.f;
#pragma unroll
              for (int j = 0; j < 8; ++j) s += (v[j].x * v[j].x + v[j].y * v[j].y) + (v[j].z * v[j].z + v[j].w * v[j].w);
              const float rs = 1.0f / sqrtf(wave_sum(s) * (1.0f / DM) + EPS);
              u32x2* o = (u32x2*)(HB + (size_t)m * DM) + lane;
#pragma unroll
              for (int j = 0; j < 8; ++j) { const f32x4 g = *((const f32x4*)a.g_pre + lane + 64 * j); u32x2 w; w.x = cvt_pk_bf16(v[j].x * rs * g.x, v[j].y * rs * g.y); w.y = cvt_pk_bf16(v[j].z * rs * g.z, v[j].w * rs * g.w); o[64 * j] = w; }
              if (!more) break;
#pragma unroll
              for (int j = 0; j < 8; ++j) v[j] = vn[j];
              m = mn; } } }
    TE(2)
    TB(3) { LAS float* scr = (LAS float*)(lds + wave * 16640);
      constexpr int NITEMS = (NPROJ / 64) * (DM / 64) + (NUP / 64) * (LAT / 64) + (DM / 64) * (DM / 64) + (FF / 64) * (DM / 64) + (DM / 64) * (FF / 64);
      int it = gw;
      if (it < NITEMS) {
          float v[64]; TrItem P = tr_decode(a, it, lane); tr_load(P, v, lane);
          for (;;) {
              tr_to_lds(P, v, scr, lane);
              const int itn = it + NGW; const bool more = itn < NITEMS; TrItem Pn = P;
              if (more) { Pn = tr_decode(a, itn, lane); tr_load(Pn, v, lane); }
              tr_store(P, scr, lane);
              if (!more) break;
              P = Pn; it = itn;
          }
      } }
    TE(3)
}

__device__ __forceinline__ void row_pass1(const Args& a) {
    const int lane = threadIdx.x & 63, gw = blockIdx.x * NWAVES + (threadIdx.x >> 6), NGW = gridDim.x * NWAVES;
    const bf16_t* Y = (const bf16_t*)(a.ws + WS_Y); bf16_t* HB = (bf16_t*)(a.ws + WS_HB);
    int m = gw; if (m >= T) return;
    f32x4 xv[8]; u32x2 yw[8];
#pragma unroll
    for (int j = 0; j < 8; ++j) { xv[j] = ((const f32x4*)(a.x + (size_t)m * DM) + lane)[64 * j]; yw[j] = ((const u32x2*)(Y + (size_t)m * DM) + lane)[64 * j]; }
    for (;;) {
        const int mn = m + NGW; const bool more = mn < T; f32x4 xn[8]; u32x2 yn[8];
        if (more) {
#pragma unroll
            for (int j = 0; j < 8; ++j) { xn[j] = ((const f32x4*)(a.x + (size_t)mn * DM) + lane)[64 * j]; yn[j] = ((const u32x2*)(Y + (size_t)mn * DM) + lane)[64 * j]; } }
        f32x4 yv[8]; float s = 0.f;
#pragma unroll
        for (int j = 0; j < 8; ++j) { yv[j] = (f32x4){bf_lo(yw[j].x), bf_hi(yw[j].x), bf_lo(yw[j].y), bf_hi(yw[j].y)};
            s += (yv[j].x * yv[j].x + yv[j].y * yv[j].y) + (yv[j].z * yv[j].z + yv[j].w * yv[j].w); }
        const float rs = 1.0f / sqrtf(wave_sum(s) * (1.0f / DM) + EPS); float s2 = 0.f;
#pragma unroll
        for (int j = 0; j < 8; ++j) { const f32x4 g = *((const f32x4*)a.g_post + lane + 64 * j); xv[j] = xv[j] + yv[j] * rs * g;
            s2 += (xv[j].x * xv[j].x + xv[j].y * xv[j].y) + (xv[j].z * xv[j].z + xv[j].w * xv[j].w); }
        const float rs2 = 1.0f / sqrtf(wave_sum(s2) * (1.0f / DM) + EPS);
        u32x2* hr = (u32x2*)(HB + (size_t)m * DM) + lane;
#pragma unroll
        for (int j = 0; j < 8; ++j) { const f32x4 g = *((const f32x4*)a.g_pre2 + lane + 64 * j);
            u32x2 w; w.x = cvt_pk_bf16(xv[j].x * rs2 * g.x, xv[j].y * rs2 * g.y); w.y = cvt_pk_bf16(xv[j].z * rs2 * g.z, xv[j].w * rs2 * g.w); hr[64 * j] = w; }
        if (!more) break;
#pragma unroll
        for (int j = 0; j < 8; ++j) { xv[j] = xn[j]; yw[j] = yn[j]; }
        m = mn;
    }
}
__device__ __forceinline__ void row_pass2(const Args& a) {
    const int lane = threadIdx.x & 63, gw = blockIdx.x * NWAVES + (threadIdx.x >> 6), NGW = gridDim.x * NWAVES;
    const bf16_t* Y = (const bf16_t*)(a.ws + WS_Y); const bf16_t* Z = (const bf16_t*)(a.ws + WS_HB);
    int m = gw; if (m >= T) return;
    f32x4 xv[8]; u32x2 yw[8], zw[8];
#pragma unroll
    for (int j = 0; j < 8; ++j) { xv[j] = ((const f32x4*)(a.x + (size_t)m * DM) + lane)[64 * j]; yw[j] = ((const u32x2*)(Y + (size_t)m * DM) + lane)[64 * j]; zw[j] = ((const u32x2*)(Z + (size_t)m * DM) + lane)[64 * j]; }
    for (;;) {
        const int mn = m + NGW; const bool more = mn < T; f32x4 xn[8]; u32x2 yn[8], zn[8];
        if (more) {
#pragma unroll
            for (int j = 0; j < 8; ++j) { xn[j] = ((const f32x4*)(a.x + (size_t)mn * DM) + lane)[64 * j]; yn[j] = ((const u32x2*)(Y + (size_t)mn * DM) + lane)[64 * j]; zn[j] = ((const u32x2*)(Z + (size_t)mn * DM) + lane)[64 * j]; } }
        float s = 0.f, s2 = 0.f;
#pragma unroll
        for (int j = 0; j < 8; ++j) { const float y0 = bf_lo(yw[j].x), y1 = bf_hi(yw[j].x), y2 = bf_lo(yw[j].y), y3 = bf_hi(yw[j].y); s += (y0 * y0 + y1 * y1) + (y2 * y2 + y3 * y3);
            const float z0 = bf_lo(zw[j].x), z1 = bf_hi(zw[j].x), z2 = bf_lo(zw[j].y), z3 = bf_hi(zw[j].y); s2 += (z0 * z0 + z1 * z1) + (z2 * z2 + z3 * z3); }
        const float rs = 1.0f / sqrtf(wave_sum(s) * (1.0f / DM) + EPS), rs2 = 1.0f / sqrtf(wave_sum(s2) * (1.0f / DM) + EPS);
        f32x4* orow = (f32x4*)(a.out + (size_t)m * DM) + lane;
#pragma unroll
        for (int j = 0; j < 8; ++j) { const f32x4 g1 = *((const f32x4*)a.g_post + lane + 64 * j), g2 = *((const f32x4*)a.g_post2 + lane + 64 * j);
            const f32x4 yv = (f32x4){bf_lo(yw[j].x), bf_hi(yw[j].x), bf_lo(yw[j].y), bf_hi(yw[j].y)}, zv = (f32x4){bf_lo(zw[j].x), bf_hi(zw[j].x), bf_lo(zw[j].y), bf_hi(zw[j].y)};
            const f32x4 x1 = xv[j] + yv * rs * g1;
            __builtin_nontemporal_store(x1 + zv * rs2 * g2, &orow[64 * j]); }
        if (!more) break;
#pragma unroll
        for (int j = 0; j < 8; ++j) { xv[j] = xn[j]; yw[j] = yn[j]; zw[j] = zn[j]; }
        m = mn;
    }
}

__device__ void naive_attn_a(const Args& a) {
    const int lane = threadIdx.x & 63, gw = blockIdx.x * NWAVES + (threadIdx.x >> 6), NGW = gridDim.x * NWAVES;
    const bf16_t* PROJ = (const bf16_t*)(a.ws + WS_PROJ); bf16_t* MIX = (bf16_t*)(a.ws + WS_HB);
    for (int it = gw; it < T * 8; it += NGW) {
        const int t = it >> 3, hh = it & 7, s = t & (SEQ - 1);
        const unsigned qw = *(const unsigned*)(PROJ + (size_t)t * NPROJ + hh * 128 + 2 * lane); const float q0 = bf_lo(qw), q1 = bf_hi(qw);
        float m = -1e30f, l = 0.f, o0 = 0.f, o1 = 0.f;
        for (int c = 0; c < 3; ++c) { const int d = c == 0 ? 1 : (c == 1 ? 4 : 16);
            for (int k = 0; k <= 128; ++k) { if (s - k * d < 0) break; const size_t tk = (size_t)(t - k * d);
                const unsigned kw = *(const unsigned*)(PROJ + tk * NPROJ + 1024 + hh * 128 + 2 * lane), vw = *(const unsigned*)(PROJ + tk * NPROJ + 2048 + hh * 128 + 2 * lane);
                const float sc = wave_sum(q0 * bf_lo(kw) + q1 * bf_hi(kw));
                const float mn = fmaxf(m, sc), al = exp2f(m - mn), p = exp2f(sc - mn);
                l = l * al + p; o0 = o0 * al + p * bf_lo(vw); o1 = o1 * al + p * bf_hi(vw); m = mn; } }
        const float il = 1.0f / l;
        *(unsigned*)(MIX + (size_t)t * DM + hh * 128 + 2 * lane) = cvt_pk_bf16(o0 * il, o1 * il);
    }
}
__device__ void naive_attn_b(const Args& a) {
    const int lane = threadIdx.x & 63, gw = blockIdx.x * NWAVES + (threadIdx.x >> 6), NGW = gridDim.x * NWAVES;
    const bf16_t* PROJ = (const bf16_t*)(a.ws + WS_PROJ); const bf16_t* QB = (const bf16_t*)(a.ws + WS_QB); const bf16_t* KVB = (const bf16_t*)(a.ws + WS_KVB); bf16_t* MIX = (bf16_t*)(a.ws + WS_HB);
    for (int it = gw; it < T * 8; it += NGW) {
        const int t = it >> 3, hh = it & 7, s = t & (SEQ - 1), t0 = t - s;
        const unsigned qw = *(const unsigned*)(QB + (size_t)t * 1536 + hh * 128 + 2 * lane); const float q0 = bf_lo(qw), q1 = bf_hi(qw), q2 = bf2f(QB[(size_t)t * 1536 + 1024 + hh * 64 + lane]);
        float m = -1e30f, l = 0.f, o0 = 0.f, o1 = 0.f;
        for (int j = 0; j <= s; ++j) { const size_t tk = (size_t)(t0 + j);
            const unsigned kw = *(const unsigned*)(KVB + tk * 2048 + hh * 256 + 2 * lane), vw = *(const unsigned*)(KVB + tk * 2048 + hh * 256 + 128 + 2 * lane);
            const float kr = bf2f(PROJ[tk * NPROJ + 4096 + lane]);
            const float sc = wave_sum(q0 * bf_lo(kw) + q1 * bf_hi(kw) + q2 * kr);
            const float mn = fmaxf(m, sc), al = exp2f(m - mn), p = exp2f(sc - mn);
            l = l * al + p; o0 = o0 * al + p * bf_lo(vw); o1 = o1 * al + p * bf_hi(vw); m = mn; }
        const float il = 1.0f / l;
        *(unsigned*)(MIX + (size_t)t * DM + 1024 + hh * 128 + 2 * lane) = cvt_pk_bf16(o0 * il, o1 * il);
    }
}

namespace att {
constexpr int NW = 8, QBLK = 32, KVBLK = 64, QB = 256;
constexpr int SHM_V = KVBLK * 128 * 2;
constexpr float THR = 8.f;
#define SBAR() __builtin_amdgcn_sched_barrier(0)
__device__ __forceinline__ int v_st(int k, int c) { const int kk = (k & ~0xC) | ((k & 4) << 1) | ((k & 8) >> 1); return ((kk >> 3) * 4 + (c >> 5)) * 512 + ((kk & 7) * 32 + (c & 31)) * 2; }
__device__ __forceinline__ int v_rd_base(int lane) { return ((lane & 3) << 3) | (((lane >> 2) & 3) << 6) | (((lane >> 4) & 1) << 5) | (((lane >> 5) & 1) << 8); }
constexpr int v_rd_off(int d0, int ks, int half) { return d0 * 512 + ks * 4096 + half * 2048; }
__device__ __forceinline__ int crow(int r, int hi) { return (r & 3) + 8 * (r >> 2) + 4 * hi; }
__device__ __forceinline__ unsigned cvtpk(float lo, float hi) { unsigned r; asm volatile("v_cvt_pk_bf16_f32 %0, %1, %2" : "=v"(r) : "v"(lo), "v"(hi)); return r; }
__device__ __forceinline__ void mask_tile(f32x16& p0, f32x16& p1, int dq, unsigned W) {
    const float NEG = -__builtin_inff();
#pragma unroll
    for (int r = 0; r < 16; ++r) { const int c = (r & 3) + 8 * (r >> 2); if ((unsigned)(dq - c) >= W) p0[r] = NEG; if ((unsigned)(dq - c - 32) >= W) p1[r] = NEG; }
}
__device__ __forceinline__ void partialSM(f32x16& p0, f32x16& p1, float& m_reg, float& mn, float& alpha) {
    float pmax = p0[0];
#pragma unroll
    for (int r = 1; r < 16; ++r) pmax = fmaxf(pmax, p0[r]);
#pragma unroll
    for (int r = 0; r < 16; ++r) pmax = fmaxf(pmax, p1[r]);
    { auto rr = __builtin_amdgcn_permlane32_swap(__float_as_uint(pmax), __float_as_uint(pmax), false, false); pmax = fmaxf(__uint_as_float(rr[0]), __uint_as_float(rr[1])); }
    if (__builtin_expect(__all((pmax - m_reg) <= THR), 1)) { mn = m_reg; alpha = 1.f; }
    else { mn = fmaxf(m_reg, pmax); alpha = __builtin_amdgcn_exp2f(m_reg - mn); m_reg = mn; }
#pragma unroll
    for (int r = 0; r < 16; ++r) p0[r] = p0[r] - mn;
#pragma unroll
    for (int r = 0; r < 16; ++r) p1[r] = p1[r] - mn;
#pragma unroll
    for (int r = 0; r < 16; ++r) p0[r] = __builtin_amdgcn_exp2f(p0[r]);
}
__device__ __forceinline__ void finishSM(f32x16& p0, f32x16& p1, float alpha, float& l_reg, bf16x8& pa0, bf16x8& pa1, bf16x8& pa2, bf16x8& pa3) {
#pragma unroll
    for (int r = 0; r < 16; ++r) p1[r] = __builtin_amdgcn_exp2f(p1[r]);
    float ps = 0;
#pragma unroll
    for (int r = 0; r < 16; ++r) ps += p0[r];
#pragma unroll
    for (int r = 0; r < 16; ++r) ps += p1[r];
    { auto rr = __builtin_amdgcn_permlane32_swap(__float_as_uint(ps), __float_as_uint(ps), false, false); ps = __uint_as_float(rr[0]) + __uint_as_float(rr[1]); }
    l_reg = l_reg * alpha + ps;
#define PK4(P, B_, OUT) do { unsigned a0 = cvtpk(P[B_+0], P[B_+1]), a1 = cvtpk(P[B_+2], P[B_+3]);                          \
        unsigned b0 = cvtpk(P[B_+4], P[B_+5]), b1 = cvtpk(P[B_+6], P[B_+7]);                                             \
        auto r0 = __builtin_amdgcn_permlane32_swap(a0, b0, false, false); auto r1 = __builtin_amdgcn_permlane32_swap(a1, b1, false, false); \
        u32x4 w = {r0[0], r1[0], r0[1], r1[1]}; OUT = __builtin_bit_cast(bf16x8, w); } while (0)
    PK4(p0, 0, pa0); PK4(p0, 8, pa1); PK4(p1, 0, pa2); PK4(p1, 8, pa3);
#undef PK4
}
template <int DK, int QREG, bool SK>
__device__ __forceinline__ void qkt(f32x16& p0, f32x16& p1, LAS const char* Kslot, int r32, int hi, const bf16x8* qr, LAS const char* qlds, bool act) {
    if (SK && !act) { const float NEG = -__builtin_inff();
#pragma unroll
        for (int r = 0; r < 16; ++r) { p0[r] = NEG; p1[r] = NEG; } return; }
    p0 = f32x16{}; p1 = f32x16{};
    const int swz = (r32 & 7) << 4;
#define KADDR(d0_) (((d0_) < 8) ? (Kslot + r32 * 256 + (((((d0_) & 3) * 16 + hi * 8) * 2) ^ swz) + ((d0_) >> 2) * 128) : (Kslot + 16384 + r32 * 128 + (((((d0_) - 8) * 16 + hi * 8) * 2) ^ swz)))
#define KROW32(d0_) (((d0_) < 8) ? 32 * 256 : 32 * 128)
    bf16x8 b0 = *(LAS const bf16x8*)(KADDR(0)), b1 = *(LAS const bf16x8*)(KADDR(0) + KROW32(0));
#pragma unroll
    for (int d0 = 0; d0 < DK / 16; ++d0) {
        bf16x8 n0 = b0, n1 = b1;
        if (d0 + 1 < DK / 16) { n0 = *(LAS const bf16x8*)(KADDR(d0 + 1)); n1 = *(LAS const bf16x8*)(KADDR(d0 + 1) + KROW32(d0 + 1)); }
        bf16x8 qf; if (d0 < QREG) qf = qr[d0]; else qf = *(LAS const bf16x8*)(qlds + (d0 - QREG) * 1024);
        p0 = __builtin_amdgcn_mfma_f32_32x32x16_bf16(b0, qf, p0, 0, 0, 0);
        p1 = __builtin_amdgcn_mfma_f32_32x32x16_bf16(b1, qf, p1, 0, 0, 0);
        b0 = n0; b1 = n1; }
#undef KADDR
#undef KROW32
}
template <bool SK>
__device__ __forceinline__ void pv_tile(f32x16* o, int vb, bf16x8 pa0, bf16x8 pa1, bf16x8 pa2, bf16x8 pa3, bool act) {
    if (SK && !act) return;
#define TRRD(dst, off) asm volatile("ds_read_b64_tr_b16 %0, %1 offset:%2" : "=&v"(dst) : "v"(vb), "i"(off) : "memory")
#define WAITL(n) asm volatile("s_waitcnt lgkmcnt(" #n ")" ::: "memory")
#define PV_D0(d0) do { s16x4 l0, l1, l2, l3, h0, h1, h2, h3; constexpr int b_ = v_rd_off(d0, 0, 0); \
        TRRD(l0, b_); TRRD(h0, b_ + 2048); TRRD(l1, b_ + 4096); TRRD(h1, b_ + 6144); TRRD(l2, b_ + 8192); TRRD(h2, b_ + 10240); TRRD(l3, b_ + 12288); TRRD(h3, b_ + 14336); \
        WAITL(6); SBAR();     \
        o[d0] = __builtin_amdgcn_mfma_f32_32x32x16_bf16(pa0, (bf16x8){l0[0], l0[1], l0[2], l0[3], h0[0], h0[1], h0[2], h0[3]}, o[d0], 0, 0, 0);   \
        WAITL(4); SBAR(); \
        o[d0] = __builtin_amdgcn_mfma_f32_32x32x16_bf16(pa1, (bf16x8){l1[0], l1[1], l1[2], l1[3], h1[0], h1[1], h1[2], h1[3]}, o[d0], 0, 0, 0);   \
        WAITL(2); SBAR(); \
        o[d0] = __builtin_amdgcn_mfma_f32_32x32x16_bf16(pa2, (bf16x8){l2[0], l2[1], l2[2], l2[3], h2[0], h2[1], h2[2], h2[3]}, o[d0], 0, 0, 0);   \
        WAITL(0); SBAR(); \
        o[d0] = __builtin_amdgcn_mfma_f32_32x32x16_bf16(pa3, (bf16x8){l3[0], l3[1], l3[2], l3[3], h3[0], h3[1], h3[2], h3[3]}, o[d0], 0, 0, 0); } while (0)
    PV_D0(0); PV_D0(1); PV_D0(2); PV_D0(3);
#undef PV_D0
#undef WAITL
#undef TRRD
}
__device__ __forceinline__ void glds16(const void* gsrc, unsigned lds_dst) { unsigned keep;
    asm volatile("s_mov_b32 %0, m0\n\ts_mov_b32 m0, %2\n\ts_nop 0\n\tglobal_load_lds_dwordx4 %1, off\n\ts_mov_b32 m0, %0" : "=&s"(keep) : "v"(gsrc), "s"(lds_dst) : "memory"); }
struct Blk {
    const bf16_t* Qn; const bf16_t* Qr; int ldq, ldqr;
    const bf16_t* Kn; const bf16_t* Kr; int ldk, ldkr;
    const bf16_t* V;
    bf16_t* O; int ldo;
    float* LSE; int ldl;
    int P0, W, skv;
};
template <int DK, bool SK>
__device__ __forceinline__ void attn_block(const Blk& B, LAS char* lds) {
    constexpr int SLOT_K = (DK == 192) ? 24576 : 16384, NKP = (DK == 192) ? 3 : 2, NVP = 2;
    constexpr int QREG = (DK == 192) ? 9 : 8;
    constexpr int OFF_K = 3 * SHM_V, OFF_WS = OFF_K + 3 * SLOT_K, OFF_Q = OFF_WS + 2048;
    const int tid = threadIdx.x, wid = __builtin_amdgcn_readfirstlane(tid >> 6), lane = tid & 63, r32 = lane & 31, hi = lane >> 5;
    const int W = B.W;
    const int lowk = B.P0 - W + 1; const int j_lo = lowk > 0 ? lowk / KVBLK : 0;
    int j_hi = (B.P0 + QB - 1) / KVBLK + 1; if (j_hi > B.skv / KVBLK) j_hi = B.skv / KVBLK;
    const int NT = j_hi - j_lo;
    const int qlo = B.P0 + wid * QBLK, qm = qlo + r32 - 4 * hi;
    LAS float* wsf = (LAS float*)(lds + OFF_WS) + wid * 64; LAS float* li_l = wsf; LAS float* al_l = wsf + 32;
    LAS char* qlds = lds + OFF_Q + wid * 3072 + lane * 16;
    const unsigned lds0 = (unsigned)(uintptr_t)lds;
    float m_reg = -1e30f, l_reg = 0; f32x16 o[4] = {};
    const int krow = 4 * wid + (lane >> 4);
    const unsigned offK = (unsigned)(krow * B.ldk + (((lane & 15) ^ (krow & 7)) << 3)) * 2u;
    const int rrow = 8 * wid + (lane >> 3);
    const unsigned offR = (unsigned)(rrow * B.ldkr + (((lane & 7) ^ (rrow & 7)) << 3)) * 2u;
    const int vkk = 8 * (wid >> 1) + ((lane & 31) >> 2), vk = (vkk & ~0xC) | ((vkk & 4) << 1) | ((vkk & 8) >> 1);
    const unsigned offV = (unsigned)(vk * B.ldk + 32 * (2 * (wid & 1) + (lane >> 5)) + (lane & 3) * 8) * 2u;
    const unsigned kdst = lds0 + OFF_K + wid * 1024, vdst = lds0 + wid * 1024;
#define KBASE(t) ((j_lo + (t)) * KVBLK)
#define DMA_K(t, slot) do { const size_t kbo_ = (size_t)KBASE(t) * (size_t)B.ldk * 2; const char* kb_ = (const char*)B.Kn + kbo_; \
        glds16(kb_ + offK, (unsigned)__builtin_amdgcn_readfirstlane(kdst + (slot) * SLOT_K)); glds16(kb_ + (size_t)B.ldk * 64 + offK, (unsigned)__builtin_amdgcn_readfirstlane(kdst + (slot) * SLOT_K + 8192)); \
        if constexpr (DK == 192) glds16((const char*)B.Kr + (size_t)KBASE(t) * (size_t)B.ldkr * 2 + offR, (unsigned)__builtin_amdgcn_readfirstlane(kdst + (slot) * SLOT_K + 16384)); } while (0)
#define DMA_V(t, slot) do { const char* vb_ = (const char*)B.V + (size_t)KBASE(t) * (size_t)B.ldk * 2; \
        glds16(vb_ + offV, (unsigned)__builtin_amdgcn_readfirstlane(vdst + (slot) * SHM_V)); glds16(vb_ + (size_t)B.ldk * 64 + offV, (unsigned)__builtin_amdgcn_readfirstlane(vdst + (slot) * SHM_V + 8192)); } while (0)
#define WAIT_BAR(N) asm volatile("s_waitcnt vmcnt(%0) lgkmcnt(0)\n\ts_barrier" :: "i"(N) : "memory")
#define RESC(a) do { if (__any((a) < 1.f)) { if (hi == 0) al_l[r32] = (a); asm volatile("s_waitcnt lgkmcnt(0)" ::: "memory");              \
                     _Pragma("unroll") for (int d_ = 0; d_ < 4; ++d_) _Pragma("unroll") for (int r = 0; r < 16; ++r) o[d_][r] *= al_l[crow(r, hi)]; } } while (0)
#define ACT(t) (KBASE(t) <= qlo + QBLK - 1 && KBASE(t) + KVBLK - 1 >= qlo - W + 1)
#define MASKT(P0_, P1_, t) do { const int kb_ = KBASE(t); if ((!SK || ACT(t)) && (kb_ + KVBLK - 1 > qlo || kb_ <= qlo + QBLK - 1 - W)) mask_tile(P0_, P1_, qm - kb_, (unsigned)W); } while (0)
    bf16x8 qr[QREG];
#pragma unroll
    for (int d0 = 0; d0 < 8; ++d0) qr[d0] = *(const bf16x8*)(B.Qn + (size_t)(wid * QBLK + r32) * B.ldq + d0 * 16 + hi * 8);
    if constexpr (DK == 192) {
        qr[8] = *(const bf16x8*)(B.Qr + (size_t)(wid * QBLK + r32) * B.ldqr + hi * 8);
#pragma unroll
        for (int d0 = 9; d0 < 12; ++d0) *(LAS bf16x8*)(qlds + (d0 - QREG) * 1024) = *(const bf16x8*)(B.Qr + (size_t)(wid * QBLK + r32) * B.ldqr + (d0 - 8) * 16 + hi * 8);
    }
    DMA_K(0, 0);
    if (NT > 1) DMA_K(1, 1);
    DMA_V(0, 0);
    if (NT > 1) { WAIT_BAR(NKP + NVP); } else { WAIT_BAR(NVP); }
    int sl_prev = 0, sl_cur = 0, sl_next = 1;
#define ROT() do { sl_prev = sl_cur; sl_cur = sl_next; sl_next = (sl_next == 2) ? 0 : sl_next + 1; } while (0)
#define ENDW(t) do { if ((t) + 2 < NT) { WAIT_BAR(NKP + NVP); } else if ((t) + 1 < NT) { WAIT_BAR(NVP); } else { WAIT_BAR(0); } } while (0)
#define ISSUE(t) do { if ((t) + 2 < NT) DMA_K((t) + 2, sl_prev_k); if ((t) + 1 < NT) DMA_V((t) + 1, sl_next); } while (0)
    f32x16 pA0, pA1, pB0, pB1; float mnA, mnB, alA, alB; bf16x8 pa0, pa1, pa2, pa3;
    { const int sl_prev_k = 2;
      ISSUE(0); SBAR();
      qkt<DK, QREG, SK>(pA0, pA1, lds + OFF_K + sl_cur * SLOT_K, r32, hi, qr, qlds, ACT(0));
      MASKT(pA0, pA1, 0); partialSM(pA0, pA1, m_reg, mnA, alA);
      ENDW(0); ROT(); }
#define STEP(PX0, PX1, mnX, alX, PY0, PY1, alY, t) do { const int sl_prev_k = sl_prev;                                        \
        ISSUE(t); SBAR();                                                                                                     \
        qkt<DK, QREG, SK>(PX0, PX1, lds + OFF_K + sl_cur * SLOT_K, r32, hi, qr, qlds, ACT(t));                               \
        finishSM(PY0, PY1, alY, l_reg, pa0, pa1, pa2, pa3); SBAR();                                                           \
        pv_tile<SK>(o, (int)lds0 + v_rd_base(lane) + sl_prev * SHM_V, pa0, pa1, pa2, pa3, ACT((t) - 1));                      \
        MASKT(PX0, PX1, (t)); partialSM(PX0, PX1, m_reg, mnX, alX);                                                           \
        RESC(alX); ENDW(t); ROT(); } while (0)
    int t = 1;
    for (; t + 1 < NT; t += 2) {
        STEP(pB0, pB1, mnB, alB, pA0, pA1, alA, t);
        STEP(pA0, pA1, mnA, alA, pB0, pB1, alB, t + 1);
    }
    if (t < NT) {
        STEP(pB0, pB1, mnB, alB, pA0, pA1, alA, t);
        finishSM(pB0, pB1, alB, l_reg, pa0, pa1, pa2, pa3); SBAR();
    } else {
        finishSM(pA0, pA1, alA, l_reg, pa0, pa1, pa2, pa3); SBAR();
    }
    pv_tile<SK>(o, (int)lds0 + v_rd_base(lane) + sl_prev * SHM_V, pa0, pa1, pa2, pa3, ACT(NT - 1));
    if (hi == 0) { li_l[r32] = l_reg; if (B.LSE) B.LSE[(size_t)(wid * QBLK + r32) * B.ldl] = m_reg + __builtin_amdgcn_logf(l_reg); }
    asm volatile("s_waitcnt lgkmcnt(0)" ::: "memory");
    float rli[16];
#pragma unroll
    for (int r = 0; r < 16; ++r) rli[r] = __builtin_amdgcn_rcpf(li_l[crow(r, hi)]);
    const char* Owb = (const char*)(B.O + (size_t)(wid * QBLK) * B.ldo);
    LAS char* stg = lds + OFF_K + wid * 4608;
    const unsigned goff = (unsigned)((lane >> 3) * B.ldo * 2 + (lane & 7) * 16);
#pragma unroll
    for (int h = 0; h < 2; ++h) {
#pragma unroll
        for (int r = 0; r < 16; ++r) {
#pragma unroll
            for (int dd = 0; dd < 2; ++dd) { const float v = o[2 * h + dd][r] * rli[r];
                *(LAS unsigned short*)(stg + crow(r, hi) * 144 + (dd * 32 + r32) * 2) = (unsigned short)cvtpk(v, v); } }
        asm volatile("s_waitcnt lgkmcnt(0)" ::: "memory");
#pragma unroll
        for (int i = 0; i < 4; ++i) { const u32x4 w = *(LAS const u32x4*)(stg + (i * 8 + (lane >> 3)) * 144 + (lane & 7) * 16);
            *(u32x4*)(Owb + (size_t)(i * 8) * (size_t)B.ldo * 2 + goff + h * 128) = w; }
        asm volatile("s_waitcnt lgkmcnt(0)" ::: "memory");
    }
    asm volatile("s_waitcnt lgkmcnt(0)\n\ts_barrier" ::: "memory");
#undef KBASE
#undef DMA_K
#undef DMA_V
#undef WAIT_BAR
#undef RESC
#undef ACT
#undef MASKT
#undef ROT
#undef ENDW
#undef ISSUE
#undef STEP
}
__device__ __forceinline__ void attn_block_a(const Blk& B, LAS char* lds) {
    constexpr int SLOT_K = 16384, OFF_K = 4 * SHM_V, OFF_WS = OFF_K + 4 * SLOT_K;
    const int tid = threadIdx.x, wid = __builtin_amdgcn_readfirstlane(tid >> 6), lane = tid & 63, r32 = lane & 31, hi = lane >> 5;
    const int W = B.W;
    const int vj = (B.P0 - 128) / KVBLK;
    const int toff = (wid >= 4) ? 2 : 0;
    const int qlo = B.P0 + wid * QBLK, qm = qlo + r32 - 4 * hi;
    LAS float* wsf = (LAS float*)(lds + OFF_WS) + wid * 64; LAS float* li_l = wsf; LAS float* al_l = wsf + 32;
    const unsigned lds0 = (unsigned)(uintptr_t)lds;
    float m_reg = -1e30f, l_reg = 0; f32x16 o[4] = {};
    const int krow = 4 * wid + (lane >> 4);
    const unsigned offK = (unsigned)(krow * B.ldk + (((lane & 15) ^ (krow & 7)) << 3)) * 2u;
    const int vkk = 8 * (wid >> 1) + ((lane & 31) >> 2), vk = (vkk & ~0xC) | ((vkk & 4) << 1) | ((vkk & 8) >> 1);
    const unsigned offV = (unsigned)(vk * B.ldk + 32 * (2 * (wid & 1) + (lane >> 5)) + (lane & 3) * 8) * 2u;
    const unsigned kdst = lds0 + OFF_K + wid * 1024, vdst = lds0 + wid * 1024;
#define TREAL(x) ((vj + (x)) < 0 ? 0 : (vj + (x)))
#define DMA_K(x) do { const char* kb_ = (const char*)B.Kn + (size_t)(TREAL(x) * KVBLK) * (size_t)B.ldk * 2; \
        glds16(kb_ + offK, (unsigned)__builtin_amdgcn_readfirstlane(kdst + ((x) & 3) * SLOT_K)); glds16(kb_ + (size_t)B.ldk * 64 + offK, (unsigned)__builtin_amdgcn_readfirstlane(kdst + ((x) & 3) * SLOT_K + 8192)); } while (0)
#define DMA_V(x) do { const char* vb_ = (const char*)B.V + (size_t)(TREAL(x) * KVBLK) * (size_t)B.ldk * 2; \
        glds16(vb_ + offV, (unsigned)__builtin_amdgcn_readfirstlane(vdst + ((x) & 3) * SHM_V)); glds16(vb_ + (size_t)B.ldk * 64 + offV, (unsigned)__builtin_amdgcn_readfirstlane(vdst + ((x) & 3) * SHM_V + 8192)); } while (0)
#define WAIT_BAR(N) asm volatile("s_waitcnt vmcnt(%0) lgkmcnt(0)\n\ts_barrier" :: "i"(N) : "memory")
#define RESC(a) do { if (__any((a) < 1.f)) { if (hi == 0) al_l[r32] = (a); asm volatile("s_waitcnt lgkmcnt(0)" ::: "memory");              \
                     _Pragma("unroll") for (int d_ = 0; d_ < 4; ++d_) _Pragma("unroll") for (int r = 0; r < 16; ++r) o[d_][r] *= al_l[crow(r, hi)]; } } while (0)
#define TW(s) ((s) + toff)
#define KB_(s) ((vj + TW(s)) * KVBLK)
#define ACT(s) ((vj + TW(s)) >= 0 && KB_(s) <= qlo + QBLK - 1 && KB_(s) + KVBLK - 1 >= qlo - W + 1)
#define MASKT(P0_, P1_, s) do { const int kb_ = KB_(s); if (ACT(s) && (kb_ + KVBLK - 1 > qlo || kb_ <= qlo + QBLK - 1 - W)) mask_tile(P0_, P1_, qm - kb_, (unsigned)W); } while (0)
#define KSLOT(s) (lds + OFF_K + (TW(s) & 3) * SLOT_K)
#define VSLOT(s) ((int)lds0 + v_rd_base(lane) + (TW(s) & 3) * SHM_V)
    bf16x8 qr[8];
#pragma unroll
    for (int d0 = 0; d0 < 8; ++d0) qr[d0] = *(const bf16x8*)(B.Qn + (size_t)(wid * QBLK + r32) * B.ldq + d0 * 16 + hi * 8);
    DMA_K(0); DMA_K(1); DMA_K(2); DMA_K(3); DMA_V(0); DMA_V(2);
    WAIT_BAR(4);
    f32x16 pA0, pA1, pB0, pB1; float mnA, mnB, alA, alB; bf16x8 pa0, pa1, pa2, pa3;
    DMA_V(1); DMA_V(3); SBAR();
    qkt<128, 8, true>(pA0, pA1, KSLOT(0), r32, hi, qr, nullptr, ACT(0));
    MASKT(pA0, pA1, 0); partialSM(pA0, pA1, m_reg, mnA, alA);
    WAIT_BAR(4);
    DMA_K(4); SBAR();
    qkt<128, 8, true>(pB0, pB1, KSLOT(1), r32, hi, qr, nullptr, ACT(1));
    finishSM(pA0, pA1, alA, l_reg, pa0, pa1, pa2, pa3); SBAR();
    pv_tile<true>(o, VSLOT(0), pa0, pa1, pa2, pa3, ACT(0));
    MASKT(pB0, pB1, 1); partialSM(pB0, pB1, m_reg, mnB, alB); RESC(alB);
    WAIT_BAR(0);
    DMA_K(5); DMA_V(4); SBAR();
    qkt<128, 8, true>(pA0, pA1, KSLOT(2), r32, hi, qr, nullptr, ACT(2));
    finishSM(pB0, pB1, alB, l_reg, pa0, pa1, pa2, pa3); SBAR();
    pv_tile<true>(o, VSLOT(1), pa0, pa1, pa2, pa3, ACT(1));
    MASKT(pA0, pA1, 2); partialSM(pA0, pA1, m_reg, mnA, alA); RESC(alA);
    WAIT_BAR(0);
    DMA_V(5); SBAR();
    qkt<128, 8, true>(pB0, pB1, KSLOT(3), r32, hi, qr, nullptr, ACT(3));
    finishSM(pA0, pA1, alA, l_reg, pa0, pa1, pa2, pa3); SBAR();
    pv_tile<true>(o, VSLOT(2), pa0, pa1, pa2, pa3, ACT(2));
    MASKT(pB0, pB1, 3); partialSM(pB0, pB1, m_reg, mnB, alB); RESC(alB);
    WAIT_BAR(0);
    finishSM(pB0, pB1, alB, l_reg, pa0, pa1, pa2, pa3); SBAR();
    pv_tile<true>(o, VSLOT(3), pa0, pa1, pa2, pa3, ACT(3));
    if (hi == 0) { li_l[r32] = l_reg; if (B.LSE) B.LSE[(size_t)(wid * QBLK + r32) * B.ldl] = m_reg + __builtin_amdgcn_logf(l_reg); }
    asm volatile("s_waitcnt lgkmcnt(0)" ::: "memory");
    float rli[16];
#pragma unroll
    for (int r = 0; r < 16; ++r) rli[r] = __builtin_amdgcn_rcpf(li_l[crow(r, hi)]);
    const char* Owb = (const char*)(B.O + (size_t)(wid * QBLK) * B.ldo);
    LAS char* stg = lds + OFF_K + wid * 4608;
    const unsigned goff = (unsigned)((lane >> 3) * B.ldo * 2 + (lane & 7) * 16);
#pragma unroll
    for (int h = 0; h < 2; ++h) {
#pragma unroll
        for (int r = 0; r < 16; ++r) {
#pragma unroll
            for (int dd = 0; dd < 2; ++dd) { const float v = o[2 * h + dd][r] * rli[r];
                *(LAS unsigned short*)(stg + crow(r, hi) * 144 + (dd * 32 + r32) * 2) = (unsigned short)cvtpk(v, v); } }
        asm volatile("s_waitcnt lgkmcnt(0)" ::: "memory");
#pragma unroll
        for (int i = 0; i < 4; ++i) { const u32x4 w = *(LAS const u32x4*)(stg + (i * 8 + (lane >> 3)) * 144 + (lane & 7) * 16);
            *(u32x4*)(Owb + (size_t)(i * 8) * (size_t)B.ldo * 2 + goff + h * 128) = w; }
        asm volatile("s_waitcnt lgkmcnt(0)" ::: "memory");
    }
    asm volatile("s_waitcnt lgkmcnt(0)\n\ts_barrier" ::: "memory");
#undef TREAL
#undef DMA_K
#undef DMA_V
#undef WAIT_BAR
#undef RESC
#undef TW
#undef KB_
#undef ACT
#undef MASKT
#undef KSLOT
#undef VSLOT
}
#undef SBAR
}

#if ATTN_A_SEAM
namespace att {
#define SBAR() __builtin_amdgcn_sched_barrier(0)
__device__ __forceinline__ Blk a_decode(const Args& a, int it) {
    const bf16_t* PROJ = (const bf16_t*)(a.ws + WS_PROJ); float* LSE = (float*)(a.ws + WS_LSE);
    const int bh = it / 48, x = it % 48, b = bh >> 3, hh = bh & 7;
    int c, d, r, qb, slen;
    if (x < 16) { c = 0; d = 1; r = 0; qb = x; slen = 4096; } else if (x < 32) { c = 1; d = 4; r = (x - 16) >> 2; qb = (x - 16) & 3; slen = 1024; } else { c = 2; d = 16; r = x - 32; qb = 0; slen = 256; }
    const long row0 = (long)b * SEQ + r;
    Blk B;
    B.ldq = d * NPROJ; B.ldk = B.ldq; B.ldqr = 0; B.ldkr = 0; B.Qr = nullptr; B.Kr = nullptr;
    B.P0 = qb * 256; B.W = 129; B.skv = slen;
    B.Qn = PROJ + (row0 + (long)B.P0 * d) * NPROJ + hh * 128;
    B.Kn = PROJ + row0 * NPROJ + 1024 + hh * 128; B.V = PROJ + row0 * NPROJ + 2048 + hh * 128;
    if (c == 0) { B.O = (bf16_t*)(a.ws + WS_HB) + (row0 + (long)B.P0 * d) * DM + hh * 128; B.ldo = d * DM; }
    else { B.O = (bf16_t*)(a.ws + WS_Y + (size_t)(c - 1) * 32 * MiB) + (row0 + (long)B.P0 * d) * 1024 + hh * 128; B.ldo = d * 1024; }
    B.LSE = LSE + (size_t)c * T * 8 + (row0 + (long)B.P0 * d) * 8 + hh; B.ldl = d * 8;
    return B;
}
__device__ __forceinline__ void attn_a_stream(const Args& a, LAS char* lds) {
    constexpr int SLOT_K = 16384, OFF_K = 4 * SHM_V, OFF_WS = OFF_K + 4 * SLOT_K;
    const int tid = threadIdx.x, wid = __builtin_amdgcn_readfirstlane(tid >> 6), lane = tid & 63, r32 = lane & 31, hi = lane >> 5;
    unsigned* qctr = (unsigned*)(a.ws + WS_QCTR);
    volatile LAS unsigned* qslot = (volatile LAS unsigned*)(lds + MISC_OFF);
    const int xq0 = blockIdx.x & 7; int qoff = 0;
    unsigned pre_v = 0u;
#define RESOLVE(v_, code_) do { unsigned vv_ = (v_); code_ = 0xffffffffu; for (;;) { const int xq_ = (xq0 + qoff) & 7; \
        if (vv_ < 192u) { code_ = (unsigned)((xq_ + 8 * (int)(vv_ / 48u)) * 48 + (int)(vv_ % 48u)); break; } \
        if (++qoff >= 8) break; vv_ = __hip_atomic_fetch_add(qctr + 64 * ((xq0 + qoff) & 7), 1u, __ATOMIC_RELAXED, __HIP_MEMORY_SCOPE_AGENT); } } while (0)
#define TICKET() __hip_atomic_fetch_add(qctr + 64 * ((xq0 + qoff) & 7), 1u, __ATOMIC_RELAXED, __HIP_MEMORY_SCOPE_AGENT)
    if (tid == 0) { unsigned c0; const unsigned v0 = TICKET(); RESOLVE(v0, c0); qslot[0] = c0; if (c0 != 0xffffffffu) pre_v = TICKET(); }
    __syncthreads();
    unsigned code = qslot[0];
    __syncthreads();
    if (code == 0xffffffffu) return;
    Blk B = a_decode(a, (int)code);
    const int toff = (wid >= 4) ? 2 : 0;
    LAS float* wsf = (LAS float*)(lds + OFF_WS) + wid * 64; LAS float* li_l = wsf; LAS float* al_l = wsf + 32;
    const unsigned lds0 = (unsigned)(uintptr_t)lds;
    const int krow = 4 * wid + (lane >> 4);
    const int vkk = 8 * (wid >> 1) + ((lane & 31) >> 2), vk = (vkk & ~0xC) | ((vkk & 4) << 1) | ((vkk & 8) >> 1);
    const unsigned kdst = lds0 + OFF_K + wid * 1024, vdst = lds0 + wid * 1024;
#define OFFK(Bx) ((unsigned)(krow * (Bx).ldk + (((lane & 15) ^ (krow & 7)) << 3)) * 2u)
#define OFFV(Bx) ((unsigned)(vk * (Bx).ldk + 32 * (2 * (wid & 1) + (lane >> 5)) + (lane & 3) * 8) * 2u)
#define VJ(Bx) (((Bx).P0 - 128) / KVBLK)
#define TREAL(Bx, x) ((VJ(Bx) + (x)) < 0 ? 0 : (VJ(Bx) + (x)))
#define DMA_K(Bx, x) do { const char* kb_ = (const char*)(Bx).Kn + (size_t)(TREAL(Bx, x) * KVBLK) * (size_t)(Bx).ldk * 2; const unsigned ok_ = OFFK(Bx); \
        glds16(kb_ + ok_, (unsigned)__builtin_amdgcn_readfirstlane(kdst + SL(x) * SLOT_K)); glds16(kb_ + (size_t)(Bx).ldk * 64 + ok_, (unsigned)__builtin_amdgcn_readfirstlane(kdst + SL(x) * SLOT_K + 8192)); } while (0)
#define DMA_V(Bx, x) do { const char* vb_ = (const char*)(Bx).V + (size_t)(TREAL(Bx, x) * KVBLK) * (size_t)(Bx).ldk * 2; const unsigned ov_ = OFFV(Bx); \
        glds16(vb_ + ov_, (unsigned)__builtin_amdgcn_readfirstlane(vdst + SL(x) * SHM_V)); glds16(vb_ + (size_t)(Bx).ldk * 64 + ov_, (unsigned)__builtin_amdgcn_readfirstlane(vdst + SL(x) * SHM_V + 8192)); } while (0)
#define QLOAD(Bx) do { _Pragma("unroll") for (int d0 = 0; d0 < 8; ++d0) qr[d0] = *(const bf16x8*)((Bx).Qn + (size_t)(wid * QBLK + r32) * (Bx).ldq + d0 * 16 + hi * 8); } while (0)
#define WAIT_BAR(N) asm volatile("s_waitcnt vmcnt(%0) lgkmcnt(0)\n\ts_barrier" :: "i"(N) : "memory")
#define RESC(a_) do { if (__any((a_) < 1.f)) { if (hi == 0) al_l[r32] = (a_); asm volatile("s_waitcnt lgkmcnt(0)" ::: "memory");              \
                     _Pragma("unroll") for (int d_ = 0; d_ < 4; ++d_) _Pragma("unroll") for (int r = 0; r < 16; ++r) o[d_][r] *= al_l[crow(r, hi)]; } } while (0)
#define TW0_0 0
#define TW0_1 2
#define TW0_2 3
#define TW0_3 1
#define TW1_0 5
#define TW1_1 3
#define TW1_2 2
#define TW1_3 4
#define TW(s) (toff ? TW1_##s : TW0_##s)
#define SL(x) (((x) == 0 || (x) == 1) ? 0 : (((x) == 5 || (x) == 4) ? 1 : ((x) == 2 ? 2 : 3)))
#define KB_(s) ((vj + TW(s)) * KVBLK)
#define ACT(s) ((vj + TW(s)) >= 0 && KB_(s) <= qlo + QBLK - 1 && KB_(s) + KVBLK - 1 >= qlo - W + 1)
#define MASKT(P0_, P1_, s) do { const int kb_ = KB_(s); if (ACT(s) && (kb_ + KVBLK - 1 > qlo || kb_ <= qlo + QBLK - 1 - W)) mask_tile(P0_, P1_, qm - kb_, (unsigned)W); } while (0)
#define KSLOT(s) (lds + OFF_K + SL(TW(s)) * SLOT_K)
#define VSLOT(s) ((int)lds0 + v_rd_base(lane) + SL(TW(s)) * SHM_V)
    bf16x8 qr[8];
    QLOAD(B); DMA_K(B, 0); DMA_K(B, 5); DMA_K(B, 2); DMA_K(B, 3); DMA_V(B, 0); DMA_V(B, 5);
    for (;;) {
        const int W = B.W, vj = VJ(B);
        const int qlo = B.P0 + wid * QBLK, qm = qlo + r32 - 4 * hi;
        float m_reg = -1e30f, l_reg = 0; f32x16 o[4] = {};
        unsigned long long tq0_ = 0; if (PROBE_T == 40 || PROBE_T == 42) tq0_ = __builtin_amdgcn_s_memrealtime();
        WAIT_BAR(4);
        if (PROBE_T == 42) { const unsigned long long t1_ = __builtin_amdgcn_s_memrealtime(), dt_ = t1_ - tq0_; while (__builtin_amdgcn_s_memrealtime() - t1_ < dt_) __builtin_amdgcn_s_sleep(2); }
        f32x16 pA0, pA1, pB0, pB1; float mnA, mnB, alA, alB; bf16x8 pa0, pa1, pa2, pa3;
        DMA_V(B, 2); DMA_V(B, 3); SBAR();
        qkt<128, 8, true>(pA0, pA1, KSLOT(0), r32, hi, qr, nullptr, ACT(0));
        MASKT(pA0, pA1, 0); partialSM(pA0, pA1, m_reg, mnA, alA);
        WAIT_BAR(4);
        DMA_K(B, 1); DMA_K(B, 4); SBAR();
        qkt<128, 8, true>(pB0, pB1, KSLOT(1), r32, hi, qr, nullptr, ACT(1));
        finishSM(pA0, pA1, alA, l_reg, pa0, pa1, pa2, pa3); SBAR();
        pv_tile<true>(o, VSLOT(0), pa0, pa1, pa2, pa3, ACT(0));
        MASKT(pB0, pB1, 1); partialSM(pB0, pB1, m_reg, mnB, alB); RESC(alB);
        if (tid == 0) { unsigned cn; RESOLVE(pre_v, cn); qslot[0] = cn; if (cn != 0xffffffffu) pre_v = TICKET(); }
        WAIT_BAR(4);
        const unsigned ncode = qslot[0]; const bool more = ncode != 0xffffffffu;
        Blk Bn = B; if (more) Bn = a_decode(a, (int)ncode);
        DMA_V(B, 1); DMA_V(B, 4); SBAR();
        qkt<128, 8, true>(pA0, pA1, KSLOT(2), r32, hi, qr, nullptr, ACT(2));
        finishSM(pB0, pB1, alB, l_reg, pa0, pa1, pa2, pa3); SBAR();
        pv_tile<true>(o, VSLOT(1), pa0, pa1, pa2, pa3, ACT(1));
        MASKT(pA0, pA1, 2); partialSM(pA0, pA1, m_reg, mnA, alA); RESC(alA);
        WAIT_BAR(4);
        SBAR();
        qkt<128, 8, true>(pB0, pB1, KSLOT(3), r32, hi, qr, nullptr, ACT(3));
        finishSM(pA0, pA1, alA, l_reg, pa0, pa1, pa2, pa3); SBAR();
        pv_tile<true>(o, VSLOT(2), pa0, pa1, pa2, pa3, ACT(2));
        MASKT(pB0, pB1, 3); partialSM(pB0, pB1, m_reg, mnB, alB); RESC(alB);
        WAIT_BAR(0);
        if (PROBE_T == 40) { const unsigned long long t1_ = __builtin_amdgcn_s_memrealtime(), dt_ = t1_ - tq0_; while (__builtin_amdgcn_s_memrealtime() - t1_ < dt_) __builtin_amdgcn_s_sleep(2); }
        unsigned long long tq1_ = 0; if (PROBE_T == 41 || PROBE_T == 43) tq1_ = __builtin_amdgcn_s_memrealtime();
        if (more) { QLOAD(Bn); DMA_K(Bn, 0); DMA_K(Bn, 5); DMA_K(Bn, 2); DMA_K(Bn, 3); }
        SBAR();
        finishSM(pB0, pB1, alB, l_reg, pa0, pa1, pa2, pa3); SBAR();
        pv_tile<true>(o, VSLOT(3), pa0, pa1, pa2, pa3, ACT(3));
        if (PROBE_T == 43) { __builtin_amdgcn_s_barrier(); const unsigned long long t1_ = __builtin_amdgcn_s_memrealtime(), dt_ = t1_ - tq1_; while (__builtin_amdgcn_s_memrealtime() - t1_ < dt_) __builtin_amdgcn_s_sleep(2); }
        unsigned long long tq2_ = 0; if (PROBE_T == 44 || PROBE_T == 45) tq2_ = __builtin_amdgcn_s_memrealtime();
        if (hi == 0) { li_l[r32] = l_reg; B.LSE[(size_t)(wid * QBLK + r32) * B.ldl] = m_reg + __builtin_amdgcn_logf(l_reg); }
        asm volatile("s_waitcnt lgkmcnt(0)" ::: "memory");
        float rli[16];
#pragma unroll
        for (int r = 0; r < 16; ++r) rli[r] = __builtin_amdgcn_rcpf(li_l[crow(r, hi)]);
        if (PROBE_T == 44) { const unsigned long long t1_ = __builtin_amdgcn_s_memrealtime(), dt_ = t1_ - tq2_; while (__builtin_amdgcn_s_memrealtime() - t1_ < dt_) __builtin_amdgcn_s_sleep(2); }
        const char* Owb = (const char*)(B.O + (size_t)(wid * QBLK) * B.ldo);
        LAS char* stg = lds + (2 + (wid >> 2)) * SHM_V + (wid & 3) * 4096;
        const unsigned goff = (unsigned)((lane >> 3) * B.ldo * 2 + (lane & 7) * 16);
#pragma unroll
        for (int h = 0; h < 2; ++h) {
#pragma unroll
            for (int r = 0; r < 16; ++r) {
#pragma unroll
                for (int dd = 0; dd < 2; ++dd) { const float v = o[2 * h + dd][r] * rli[r];
                    *(LAS unsigned short*)(stg + crow(r, hi) * 128 + (dd * 32 + r32) * 2) = (unsigned short)cvtpk(v, v); } }
            asm volatile("s_waitcnt lgkmcnt(0)" ::: "memory");
#pragma unroll
            for (int i = 0; i < 4; ++i) { const u32x4 w = *(LAS const u32x4*)(stg + (i * 8 + (lane >> 3)) * 128 + (lane & 7) * 16);
                *(u32x4*)(Owb + (size_t)(i * 8) * (size_t)B.ldo * 2 + goff + h * 128) = w; }
            asm volatile("s_waitcnt lgkmcnt(0)" ::: "memory");
        }
        if (PROBE_T == 45) { const unsigned long long t1_ = __builtin_amdgcn_s_memrealtime(), dt_ = t1_ - tq2_; while (__builtin_amdgcn_s_memrealtime() - t1_ < dt_) __builtin_amdgcn_s_sleep(2); }
        asm volatile("s_waitcnt lgkmcnt(0)\n\ts_barrier" ::: "memory");
        if (PROBE_T == 41) { const unsigned long long t1_ = __builtin_amdgcn_s_memrealtime(), dt_ = t1_ - tq1_; while (__builtin_amdgcn_s_memrealtime() - t1_ < dt_) __builtin_amdgcn_s_sleep(2); }
        if (!more) break;
        DMA_V(Bn, 0); DMA_V(Bn, 5);
        B = Bn;
    }
#undef RESOLVE
#undef TICKET
#undef OFFK
#undef OFFV
#undef VJ
#undef TREAL
#undef DMA_K
#undef DMA_V
#undef QLOAD
#undef WAIT_BAR
#undef RESC
#undef TW
#undef SL
#undef KB_
#undef ACT
#undef MASKT
#undef KSLOT
#undef VSLOT
}
#undef SBAR
}
#endif

__device__ __forceinline__ void fast_attn_a(const Args& a, LAS char* lds) {
#if ATTN_A_SEAM
    att::attn_a_stream(a, lds); return;
#endif
    const bf16_t* PROJ = (const bf16_t*)(a.ws + WS_PROJ);
    float* LSE = (float*)(a.ws + WS_LSE);
    unsigned* qctr = (unsigned*)(a.ws + WS_QCTR);
    volatile LAS unsigned* qslot = (volatile LAS unsigned*)(lds + MISC_OFF);
    const int xq0 = blockIdx.x & 7; int qoff = 0;
    unsigned pre_v = 0u; bool have_pre = false;
    for (;;) {
        if (threadIdx.x == 0) { unsigned code = 0xffffffffu; int q = qoff; bool use_pre = have_pre;
            for (; q < 8; ++q) { const int xq = (xq0 + q) & 7; unsigned v;
                if (use_pre) v = pre_v; else v = __hip_atomic_fetch_add(qctr + 64 * xq, 1u, __ATOMIC_RELAXED, __HIP_MEMORY_SCOPE_AGENT);
                use_pre = false;
                if (v < 192u) { code = (unsigned)((xq + 8 * (int)(v / 48u)) * 48 + (int)(v % 48u)); break; } }
            qslot[0] = code; qslot[1] = (unsigned)q; }
        __syncthreads();
        const unsigned code = qslot[0]; qoff = (int)qslot[1];
        __syncthreads();
        if (code == 0xffffffffu) break;
        if (threadIdx.x == 0) { pre_v = __hip_atomic_fetch_add(qctr + 64 * ((xq0 + qoff) & 7), 1u, __ATOMIC_RELAXED, __HIP_MEMORY_SCOPE_AGENT); have_pre = true; }
        const int it = (int)code;
        const int bh = it / 48, x = it % 48, b = bh >> 3, hh = bh & 7;
        int c, d, r, qb, slen;
        if (x < 16) { c = 0; d = 1; r = 0; qb = x; slen = 4096; } else if (x < 32) { c = 1; d = 4; r = (x - 16) >> 2; qb = (x - 16) & 3; slen = 1024; } else { c = 2; d = 16; r = x - 32; qb = 0; slen = 256; }
        const long row0 = (long)b * SEQ + r;
        att::Blk B;
        B.ldq = d * NPROJ; B.ldk = B.ldq; B.ldqr = 0; B.ldkr = 0; B.Qr = nullptr; B.Kr = nullptr;
        B.P0 = qb * 256; B.W = 129; B.skv = slen;
        B.Qn = PROJ + (row0 + (long)B.P0 * d) * NPROJ + hh * 128;
        B.Kn = PROJ + row0 * NPROJ + 1024 + hh * 128; B.V = PROJ + row0 * NPROJ + 2048 + hh * 128;
        if (c == 0) { B.O = (bf16_t*)(a.ws + WS_HB) + (row0 + (long)B.P0 * d) * DM + hh * 128; B.ldo = d * DM; }
        else { B.O = (bf16_t*)(a.ws + WS_Y + (size_t)(c - 1) * 32 * MiB) + (row0 + (long)B.P0 * d) * 1024 + hh * 128; B.ldo = d * 1024; }
        B.LSE = LSE + (size_t)c * T * 8 + (row0 + (long)B.P0 * d) * 8 + hh; B.ldl = d * 8;
#if ATTN_A_SKEW
        att::attn_block_a(B, lds);
#else
        att::attn_block<128, true>(B, lds);
#endif
    }
}
__device__ __forceinline__ void merge_a(const Args& a) {
    const float* LSE = (const float*)(a.ws + WS_LSE); bf16_t* MIX = (bf16_t*)(a.ws + WS_HB);
    const bf16_t* O1 = (const bf16_t*)(a.ws + WS_Y); const bf16_t* O2 = (const bf16_t*)(a.ws + WS_Y + 32 * MiB);
    const long total = (long)T * 128;
    for (long idx = (long)blockIdx.x * NTHREADS + threadIdx.x; idx < total; idx += (long)gridDim.x * NTHREADS) {
        const long t = idx >> 7; const int cg8 = (int)(idx & 127), hh = cg8 >> 4;
        const float l0 = LSE[t * 8 + hh], l1 = LSE[(size_t)T * 8 + t * 8 + hh], l2 = LSE[(size_t)2 * T * 8 + t * 8 + hh];
        const float mx = fmaxf(l0, fmaxf(l1, l2)); float w0 = exp2f(l0 - mx), w1 = exp2f(l1 - mx), w2 = exp2f(l2 - mx); const float inv = 1.0f / (w0 + w1 + w2); w0 *= inv; w1 *= inv; w2 *= inv;
        float v0[8], v1[8], v2[8]; load8f(MIX + t * DM + cg8 * 8, v0); load8f(O1 + t * 1024 + cg8 * 8, v1); load8f(O2 + t * 1024 + cg8 * 8, v2);
#pragma unroll
        for (int j = 0; j < 8; ++j) v0[j] = w0 * v0[j] + w1 * v1[j] + w2 * v2[j];
        store8(MIX + t * DM + cg8 * 8, v0);
    }
}
__device__ __forceinline__ void fast_attn_b(const Args& a, LAS char* lds) {
    const bf16_t* PROJ = (const bf16_t*)(a.ws + WS_PROJ); const bf16_t* QB = (const bf16_t*)(a.ws + WS_QB); const bf16_t* KVB = (const bf16_t*)(a.ws + WS_KVB); bf16_t* MIX = (bf16_t*)(a.ws + WS_HB);
    for (int it0 = blockIdx.x; it0 < 256; it0 += gridDim.x) {
        const int it = (gridDim.x == 256) ? ((it0 & 7) * 32 + (it0 >> 3)) : it0;
        const int bh = it >> 3, s8 = it & 7, b = bh >> 3, hh = bh & 7;
        for (int pass = 0; pass < 2; ++pass) {
            const int qb = pass ? 15 - s8 : s8; const long row0 = (long)b * SEQ;
            att::Blk B;
            B.P0 = qb * 256; B.W = 1 << 30; B.skv = SEQ;
            B.Qn = QB + (row0 + B.P0) * 1536 + hh * 128; B.ldq = 1536; B.Qr = QB + (row0 + B.P0) * 1536 + 1024 + hh * 64; B.ldqr = 1536;
            B.Kn = KVB + row0 * 2048 + hh * 256; B.ldk = 2048; B.Kr = PROJ + row0 * NPROJ + 4096; B.ldkr = NPROJ;
            B.V = KVB + row0 * 2048 + hh * 256 + 128;
            B.O = MIX + (row0 + B.P0) * DM + 1024 + hh * 128; B.ldo = DM; B.LSE = nullptr; B.ldl = 0;
            att::attn_block<192, false>(B, lds);
        }
    }
}


__device__ __forceinline__ void kr_phase(const Args& a, const Ctx& C, LAS unsigned char* lds) {
    constexpr int RSB = 2064;
    const int tid = threadIdx.x, wid = tid >> 6, lane = tid & 63, r16 = lane & 15, quad = lane >> 4;
    const bf16_t* HB = (const bf16_t*)(a.ws + WS_HB); const bf16_t* BT = (const bf16_t*)(a.ws + WS_BTIN) + (size_t)4096 * DM;
    for (int it = blockIdx.x; it < T / 64; it += gridDim.x) {
        const int tok = it * 64 + (wid >> 1) * 16 + r16;
        f32x4 acc[4];
#pragma unroll
        for (int nt = 0; nt < 4; ++nt) acc[nt] = (f32x4){0.f, 0.f, 0.f, 0.f};
#pragma unroll 1
        for (int kh = 0; kh < 2; ++kh) {
            __syncthreads();
#pragma unroll
            for (int i = 0; i < 16; ++i) { const int id = tid + 512 * i, row = id >> 7, c = id & 127;
                *(LAS u32x4*)(lds + row * RSB + c * 16) = *(const u32x4*)(BT + (size_t)row * DM + kh * 1024 + c * 8); }
            __syncthreads();
            const bf16_t* hp = HB + (size_t)tok * DM + kh * 1024 + (wid & 1) * 512 + quad * 8;
            const LAS unsigned char* bp = lds + r16 * RSB + ((wid & 1) * 512 + quad * 8) * 2;
#pragma unroll 8
            for (int k0 = 0; k0 < 512; k0 += 32) {
                const bf16x8 hv = *(const bf16x8*)(hp + k0);
#pragma unroll
                for (int nt = 0; nt < 4; ++nt) { const bf16x8 wv = *(const LAS bf16x8*)(bp + nt * 16 * RSB + k0 * 2); acc[nt] = __builtin_amdgcn_mfma_f32_16x16x32_bf16(wv, hv, acc[nt], 0, 0, 0); }
            }
        }
        __syncthreads();
        LAS f32x4* xch = (LAS f32x4*)lds + (wid >> 1) * 256 + lane;
        if (wid & 1) {
#pragma unroll
            for (int nt = 0; nt < 4; ++nt) xch[nt * 64] = acc[nt]; }
        __syncthreads();
        if ((wid & 1) == 0) {
#pragma unroll
            for (int nt = 0; nt < 4; ++nt) { const f32x4 v = acc[nt] + xch[nt * 64];
                f32x4 pv; pv.x = __shfl_xor(v.x, 16); pv.y = __shfl_xor(v.y, 16); pv.z = __shfl_xor(v.z, 16); pv.w = __shfl_xor(v.w, 16);
                const int i0 = 16 * (nt >> 1) + 8 * (nt & 1) + 4 * (quad >> 1);
                const f32x4 cs = *(const f32x4*)(C.COSB + (size_t)tok * 32 + i0), sn = *(const f32x4*)(C.SINB + (size_t)tok * 32 + i0);
                f32x4 o; if ((quad & 1) == 0) o = v * cs - pv * sn; else o = v * cs + pv * sn;
                u32x2 w; w.x = cvt_pk_bf16(o.x, o.y); w.y = cvt_pk_bf16(o.z, o.w);
                *(u32x2*)(C.PROJ + (size_t)tok * NPROJ + 4096 + nt * 16 + quad * 4) = w; }
        }
    }
    __syncthreads();
}

#define RLX_AGENT __ATOMIC_RELAXED, __HIP_MEMORY_SCOPE_AGENT
#define XB_TMO      128
#define XB_XCNT(j)  (256  + 64 * (j))
#define XB_XSUB(j)  (1280 + 64 * (j))
#define XB_XGEN(j)  (2304 + 64 * (j))
#define XB_TOP      3328
#define XB_TOPGEN   3392
#define XCD_BAR_WORDS 3456
#define XB_SPIN_CAP (1u << 18)

__device__ __forceinline__ unsigned xb_ld(unsigned* p)              { return __hip_atomic_load(p, __ATOMIC_RELAXED, __HIP_MEMORY_SCOPE_AGENT); }
__device__ __forceinline__ unsigned xb_add(unsigned* p, unsigned v) { return __hip_atomic_fetch_add(p, v, __ATOMIC_RELAXED, __HIP_MEMORY_SCOPE_AGENT); }
__device__ __forceinline__ unsigned xb_xcc_id() { return (unsigned)__builtin_amdgcn_s_getreg((3 << 11) | 20) & 0xFu; }
#define XB_SPIN(cond, bar) do { unsigned _sp = 0; while (cond) { __builtin_amdgcn_s_sleep(1); \
    if ((++_sp & 255u) == 0u) { if (xb_ld(&(bar)[XB_TMO])) break; if (_sp > XB_SPIN_CAP) { atomicAdd(&(bar)[XB_TMO], 1u); break; } } } } while (0)

struct XcdBarrier {
    unsigned* bar; unsigned x;
    volatile LAS unsigned* st;
};

__device__ __forceinline__ XcdBarrier xcd_barrier_post(unsigned* bar, volatile LAS unsigned* st) {
    XcdBarrier b; b.bar = bar; b.x = xb_xcc_id(); b.st = st;
    if (threadIdx.x == 0) (void)xb_add(&bar[XB_XCNT(b.x)], 1u);
    return b;
}
__device__ __forceinline__ void xcd_barrier_complete(unsigned* bar, unsigned x, unsigned& nloc, unsigned& nx) {
    const unsigned G = gridDim.x * gridDim.y * gridDim.z;
    unsigned sum, cnt, mine, sp = 0u;
    for (;;) {
        sum = 0u; cnt = 0u; mine = 0u;
#pragma unroll
        for (unsigned j = 0; j < 16; ++j) { const unsigned c = xb_ld(&bar[XB_XCNT(j)]); sum += c; cnt += (c > 0u) ? 1u : 0u; mine = (j == x) ? c : mine; }
        if (sum == G) break;
        __builtin_amdgcn_s_sleep(1);
        if ((++sp & 255u) == 0u) { if (xb_ld(&bar[XB_TMO])) break; if (sp > XB_SPIN_CAP) { atomicAdd(&bar[XB_TMO], 1u); break; } }
    }
    nloc = mine > 0u ? mine : 1u; nx = cnt > 0u ? cnt : 1u;
}

__device__ __forceinline__ void xcd_barrier(const XcdBarrier& b) {
    asm volatile("s_waitcnt vmcnt(0)" ::: "memory");
    __syncthreads();
    if (threadIdx.x == 0) {
        unsigned* bar = b.bar;
        __builtin_amdgcn_s_waitcnt(0);
        unsigned nloc = b.st[0], nx = b.st[1];
        if (nloc == 0u) { xcd_barrier_complete(bar, b.x, nloc, nx); b.st[0] = nloc; b.st[1] = nx; }
        const unsigned old = xb_add(&bar[XB_XSUB(b.x)], 1u);
        const unsigned gen = old / nloc;
        if (old + 1u == (gen + 1u) * nloc) {
            __builtin_amdgcn_fence(__ATOMIC_RELEASE, "agent");
            asm volatile("s_waitcnt vmcnt(0)" ::: "memory");
            const unsigned og = xb_add(&bar[XB_TOP], 1u);
            const unsigned tg = og / nx;
            if (og + 1u == (tg + 1u) * nx) xb_add(&bar[XB_TOPGEN], 1u);
            else XB_SPIN(xb_ld(&bar[XB_TOPGEN]) == tg, bar);
            __builtin_amdgcn_fence(__ATOMIC_ACQUIRE, "agent");
            xb_add(&bar[XB_XGEN(b.x)], 1u);
            asm volatile("s_waitcnt vmcnt(0)" ::: "memory");
        } else {
            XB_SPIN(xb_ld(&bar[XB_XGEN(b.x)]) == gen, bar);
            __builtin_amdgcn_fence(__ATOMIC_ACQUIRE, "agent");
            asm volatile("s_waitcnt vmcnt(0)" ::: "memory");
        }
    }
    __syncthreads();
}

__global__ void __launch_bounds__(NTHREADS) hybrid_fwd(Args args) {
    extern __shared__ __attribute__((aligned(16))) unsigned char lds_raw[];
    LAS unsigned char* lds = (LAS unsigned char*)lds_raw;
    cg::grid_group grid = cg::this_grid();
    unsigned char* ws = args.ws;
    volatile LAS unsigned* MISC = (volatile LAS unsigned*)(lds + MISC_OFF);
    if (threadIdx.x < 16) MISC[threadIdx.x] = 0u;
    __syncthreads();
    XcdBarrier bar = xcd_barrier_post((unsigned*)(ws + WS_BAR), MISC + 8);
    if (args.ph_hi > 1000) grid.sync();
    Ctx C; C.PROJ = (bf16_t*)(ws + WS_PROJ); C.QB = (bf16_t*)(ws + WS_QB); C.KVB = (bf16_t*)(ws + WS_KVB); C.Y = (bf16_t*)(ws + WS_Y); C.U = (bf16_t*)(ws + WS_U);
    C.SSQ = (float*)(ws + WS_SSQ); C.COSA = (const float*)(ws + WS_COSA); C.SINA = (const float*)(ws + WS_SINA); C.COSB = (const float*)(ws + WS_COSB); C.SINB = (const float*)(ws + WS_SINB);
    const int lo = args.ph_lo, hi = args.ph_hi;
#define IN(k) (lo <= (k) && (k) < hi)
#define SEAM(k) do { if (IN(k) && IN((k) + 1)) xcd_barrier(bar); } while (0)
#define GSYNC() xcd_barrier(bar)
#if FAST_GEMM
#define RUN_GEMM(KIND, g) RUN_GEMM_C(KIND, g, C)
#define RUN_GEMM_C(KIND, g, CC) do { pg8::StaticOrder S_; S_.init((g).M, (g).N, (int)gridDim.x, (int)blockIdx.x); S_.wgm = (KIND == EK_OUT) ? 4 : WGM_OTHER; S_.rev = (KIND == EK_OUT) ? REV_OUT : 0; pg8::EpiK<KIND> E_{CC}; \
        pg8::gemm_phase<pg8::EpiK<KIND>, pg8::StaticOrder, (KIND == EK_UP ? UP_ALIGN : GEMM_ALIGN), GEMM_SP2>(lds, (g), S_, E_); __syncthreads(); } while (0)
#else
#define RUN_GEMM(KIND, g) naive_gemm<KIND>((g), C)
#endif
#ifndef PROBE_MASK
#define PROBE_MASK 0
#endif
#ifndef PROBE_T
#define PROBE_T -1
#endif
#define TIMED(id, stmt) do { unsigned long long t0_ = 0; if (PROBE_T == (id)) t0_ = __builtin_amdgcn_s_memrealtime(); stmt; \
        if (PROBE_T == (id)) { __syncthreads(); const unsigned long long t1_ = __builtin_amdgcn_s_memrealtime(), dt_ = t1_ - t0_; while (__builtin_amdgcn_s_memrealtime() - t1_ < dt_) __builtin_amdgcn_s_sleep(4); } } while (0)
#define PH0() do { if (IN(0)) { TIMED(0, p0_prologue(args, lds)); } } while (0)
#define PH1() do { if (IN(1)) { const GemmDesc g{(const bf16_t*)(ws + WS_HB), (const bf16_t*)(ws + WS_BTIN), T, 4096, DM, DM, 0, 0, 0}; TIMED(10, RUN_GEMM(EK_PROJ, g)); TIMED(11, kr_phase(args, C, lds)); } } while (0)
#if FAST_ATTN_A
#define PH2A() fast_attn_a(args, (LAS char*)lds)
#define PH3A() merge_a(args)
#else
#define PH2A() naive_attn_a(args)
#define PH3A() do {} while (0)
#endif
#if FAST_ATTN_B
#define PH3B() fast_attn_b(args, (LAS char*)lds)
#else
#define PH3B() naive_attn_b(args)
#endif
#define PH2() do { if (IN(2)) { const GemmDesc g{(const bf16_t*)(ws + WS_PROJ), (const bf16_t*)(ws + WS_BTUP), T, NUP, LAT, NPROJ, 6, 3072 * 2, 3584 * 2}; TIMED(22, { TIMED(20, RUN_GEMM(EK_UP, g)); TIMED(21, PH2A()); }); } } while (0)
#define PH3() do { if (IN(3)) { TIMED(30, PH3A()); TIMED(31, PH3B()); } } while (0)
#define PH4() do { if (IN(4)) { const GemmDesc g{(const bf16_t*)(ws + WS_HB), (const bf16_t*)(ws + WS_BTOUT), T, DM, DM, DM, 0, 0, 0}; TIMED(4, RUN_GEMM(EK_OUT, g)); } } while (0)
#define PH5() do { if (IN(5)) { TIMED(5, row_pass1(args)); } } while (0)
#define PH6() do { if (IN(6)) { const GemmDesc g{(const bf16_t*)(ws + WS_HB), (const bf16_t*)(ws + WS_BTFU), T, FF, DM, DM, 0, 0, 0}; TIMED(6, RUN_GEMM(EK_FU, g)); } } while (0)
#define PH7() do { if (IN(7)) { const GemmDesc g{(const bf16_t*)(ws + WS_U), (const bf16_t*)(ws + WS_BTFD), T, DM, FF, FF, 0, 0, 0}; Ctx C7 = C; C7.Y = (bf16_t*)(ws + WS_HB); TIMED(7, RUN_GEMM_C(EK_OUT, g, C7)); } } while (0)
    PH0();
#if (PROBE_MASK >> 0) & 1
    GSYNC(); PH0();
#endif
    SEAM(0);
    PH1();
    SEAM(1);
    PH2();
    SEAM(2);
    PH3();
#if (PROBE_MASK >> 2) & 1
    GSYNC(); PH2(); GSYNC(); PH3();
#endif
#if (PROBE_MASK >> 8) & 1
    GSYNC(); PH2A(); GSYNC(); PH3A();
#endif
#if (PROBE_MASK >> 9) & 1
    GSYNC(); PH3B();
#endif
#if (PROBE_MASK >> 10) & 1
    for (int i_ = 0; i_ < 20; ++i_) GSYNC();
#endif
    SEAM(3);
    PH4();
#if (PROBE_MASK >> 4) & 1
    GSYNC(); PH4();
#endif
    SEAM(4);
    PH5();
#if (PROBE_MASK >> 5) & 1
    GSYNC(); PH5();
#endif
    SEAM(5);
#if (PROBE_MASK >> 11) & 1
    { const unsigned long long t0_ = __builtin_amdgcn_s_memrealtime(); while (__builtin_amdgcn_s_memrealtime() - t0_ < 10000ull) __builtin_amdgcn_s_sleep(16); }
#endif
    PH6();
#if (PROBE_MASK >> 6) & 1
    GSYNC(); PH6();
#endif
    SEAM(6);
    PH7();
#if (PROBE_MASK >> 7) & 1
    GSYNC(); PH7();
#endif
    SEAM(7);
    if (IN(8)) { TIMED(8, row_pass2(args)); }
}

extern "C" void kernel_launch(void* const* d_in, const int* in_sizes, int n_in, void* d_out, int out_size, void* d_ws, size_t ws_size, hipStream_t stream) {
    static int grid = 0;
    if (grid == 0) {
        if (n_in != 14 || in_sizes[0] != T * DM || out_size != T * DM || ws_size < WS_END) { fprintf(stderr, "kernel_launch: unexpected shapes / workspace (n_in %d, ws %zu, need %zu)\n", n_in, ws_size, (size_t)WS_END); grid = -1; return; }
        int dev = 0, cus = 0, per_cu = 0;
        (void)hipGetDevice(&dev); (void)hipDeviceGetAttribute(&cus, hipDeviceAttributeMultiprocessorCount, dev);
        if (hipFuncSetAttribute((const void*)hybrid_fwd, hipFuncAttributeMaxDynamicSharedMemorySize, LDS_BYTES) != hipSuccess) { fprintf(stderr, "kernel_launch: hipFuncSetAttribute failed\n"); grid = -1; return; }
        if (hipOccupancyMaxActiveBlocksPerMultiprocessor(&per_cu, (const void*)hybrid_fwd, NTHREADS, LDS_BYTES) != hipSuccess || per_cu < 1) { fprintf(stderr, "kernel_launch: occupancy query failed (%d)\n", per_cu); (void)hipGetLastError(); per_cu = 1; }
        grid = cus * (per_cu > 1 ? 1 : per_cu);
        if (grid <= 0) grid = 256;
    }
    if (grid < 0) return;
    Args a{};
    a.x = (const float*)d_in[0]; a.pos = (const int*)d_in[1]; a.g_pre = (const float*)d_in[2]; a.g_post = (const float*)d_in[3]; a.w_in = (const float*)d_in[4];
    a.g_q = (const float*)d_in[5]; a.g_kv = (const float*)d_in[6]; a.w_uq = (const float*)d_in[7]; a.w_ukv = (const float*)d_in[8]; a.w_out = (const float*)d_in[9];
    a.g_pre2 = (const float*)d_in[10]; a.g_post2 = (const float*)d_in[11]; a.w_up = (const float*)d_in[12]; a.w_down = (const float*)d_in[13];
    a.out = (float*)d_out; a.ws = (unsigned char*)d_ws;
    if (hipMemsetAsync((char*)d_ws + WS_BAR, 0, 16 * 1024 + 2048, stream) != hipSuccess) { fprintf(stderr, "kernel_launch: memset of the barrier words failed\n"); return; }
    constexpr int NPH = 9;
    for (int li = 0; li < MK_N_LAUNCHES; ++li) {
        a.ph_lo = (MK_N_LAUNCHES == 1) ? 0 : li; a.ph_hi = (MK_N_LAUNCHES == 1) ? NPH : li + 1;
        void* kargs[] = {&a};
        const hipError_t e = hipLaunchCooperativeKernel((const void*)hybrid_fwd, dim3(grid), dim3(NTHREADS), kargs, LDS_BYTES, stream);
        if (e != hipSuccess) { fprintf(stderr, "kernel_launch: cooperative launch %d failed: %s (grid %d)\n", li, hipGetErrorString(e), grid); break; }
    }
}
```
